# Optimizing an MI355X kernel written in HIP

```python
import jax, jax.numpy as jnp
from jax import lax
import numpy as np

D_MODEL = 1024
BATCH = 32
SEQ = 256
DEPTH = 2
DEC_BATCH = 4
DEC_SEQ = 4096
PAST_LEN = 256

GRID_W = 64
HEAD_DIM = 64
N_Q_HEADS = 8
N_KV_HEADS = 2
N_GROUPS = N_Q_HEADS // N_KV_HEADS
ATTN_WIDTH = N_Q_HEADS * HEAD_DIM
KV_WIDTH = N_KV_HEADS * HEAD_DIM
N_DN_HEADS = 8
DK = 64
DV = 64
DN_K_WIDTH = N_DN_HEADS * DK
DN_V_WIDTH = N_DN_HEADS * DV
CONV_W = 3
CONV_CH = 2 * DN_K_WIDTH + DN_V_WIDTH
CHUNK = 64
Q_BLOCK = 128
D_FF = 4 * D_MODEL
ROPE_THETA = 10000.0
ROPE_FREQS = HEAD_DIM // 4
EPS = 1e-6
SPLIT_SIZES = (ATTN_WIDTH, KV_WIDTH, KV_WIDTH, DN_K_WIDTH, DN_K_WIDTH, DN_V_WIDTH, DN_V_WIDTH,
               2 * N_DN_HEADS, 2 * N_DN_HEADS, D_MODEL, D_MODEL)
IN_WIDTH = sum(SPLIT_SIZES)

kernel_name = 'hybrid_gqa_deltanet_diffusion_step'


def rmsnorm(x, g):
    xf = x.astype(jnp.float32)
    y = xf * lax.rsqrt(jnp.mean(xf * xf, axis=-1, keepdims=True) + EPS)
    return (y * g.astype(jnp.float32)).astype(x.dtype)


def l2norm(x):
    xf = x.astype(jnp.float32)
    return xf * lax.rsqrt(jnp.sum(xf * xf, axis=-1, keepdims=True) + EPS)


def adaln(c, w_mod, b_mod):
    return jax.nn.silu(c) @ w_mod + b_mod


def axial_rope(n_tokens):
    rows = n_tokens // GRID_W
    t = jnp.arange(rows * GRID_W)
    row = (t // GRID_W).astype(jnp.float32)
    col = (t % GRID_W).astype(jnp.float32)
    inv = ROPE_THETA ** (-jnp.arange(ROPE_FREQS, dtype=jnp.float32) / ROPE_FREQS)
    ang = jnp.concatenate([row[:, None] * inv, col[:, None] * inv], axis=-1)
    return jnp.cos(ang), jnp.sin(ang)


def apply_rope(x, cos, sin):
    half = x.shape[-1] // 2
    x1, x2 = x[..., :half], x[..., half:]
    cos = cos.astype(x.dtype)
    sin = sin.astype(x.dtype)
    return jnp.concatenate([x1 * cos - x2 * sin, x2 * cos + x1 * sin], axis=-1)


def short_conv(x, w):
    T = x.shape[1]
    pad = CONV_W // 2
    xp = jnp.pad(x, ((0, 0), (pad, CONV_W - 1 - pad), (0, 0)))
    y = xp[:, 0:T] * w[0]
    for j in range(1, CONV_W):
        y = y + xp[:, j:j + T] * w[j]
    return jax.nn.silu(y)


def block_attention(q, k, v):
    B, KV, G, T, hd = q.shape
    nb = T // Q_BLOCK
    qb = jnp.moveaxis(q.reshape(B, KV, G, nb, Q_BLOCK, hd), 3, 0)
    scale = HEAD_DIM ** -0.5

    def one_block(qblk):
        s = jnp.einsum('bkgqd,bkjd->bkgqj', qblk, k).astype(jnp.float32) * scale
        p = jax.nn.softmax(s, axis=-1).astype(v.dtype)
        return jnp.einsum('bkgqj,bkjd->bkgqd', p, v)

    ob = lax.map(one_block, qb)
    return jnp.moveaxis(ob, 0, 3).reshape(B, KV * G, T, hd)


def delta_chunked(q, k, v, log_a, beta, s0):
    B, H, T, dk = q.shape
    dv = v.shape[-1]
    n = T // CHUNK
    q = q.reshape(B, H, n, CHUNK, dk)
    k = k.reshape(B, H, n, CHUNK, dk)
    v = v.reshape(B, H, n, CHUNK, dv)
    g = jnp.cumsum(log_a.reshape(B, H, n, CHUNK), axis=-1)
    b = beta.reshape(B, H, n, CHUNK)
    idx = jnp.arange(CHUNK)
    incl = idx[:, None] >= idx[None, :]
    strict = idx[:, None] > idx[None, :]
    decay = jnp.exp(jnp.where(incl, g[..., :, None] - g[..., None, :], -jnp.inf))
    kk = jnp.einsum('bhnid,bhnjd->bhnij', k, k)
    lmat = jnp.where(strict, b[..., :, None] * kk * decay, 0.0) + jnp.eye(CHUNK, dtype=kk.dtype)
    w = lax.linalg.triangular_solve(lmat, (b * jnp.exp(g))[..., None] * k,
                                    left_side=True, lower=True, unit_diagonal=True)
    u = lax.linalg.triangular_solve(lmat, b[..., None] * v,
                                    left_side=True, lower=True, unit_diagonal=True)
    qk = jnp.einsum('bhnid,bhnjd->bhnij', q, k) * decay
    q_dec = q * jnp.exp(g)[..., None]
    g_last = g[..., -1]
    k_dec = k * jnp.exp(g_last[..., None] - g)[..., None]
    xs = (jnp.moveaxis(w, 2, 0), jnp.moveaxis(u, 2, 0), jnp.moveaxis(q_dec, 2, 0),
          jnp.moveaxis(qk, 2, 0), jnp.moveaxis(k_dec, 2, 0), jnp.moveaxis(jnp.exp(g_last), 2, 0))

    def step(S, inp):
        w_c, u_c, qd_c, qk_c, kd_c, eg_c = inp
        u_c = u_c - jnp.einsum('bhcd,bhde->bhce', w_c, S)
        o_c = jnp.einsum('bhcd,bhde->bhce', qd_c, S) + jnp.einsum('bhij,bhje->bhie', qk_c, u_c)
        S = eg_c[..., None, None] * S + jnp.einsum('bhcd,bhce->bhde', kd_c, u_c)
        return S, o_c

    S, o = lax.scan(step, s0, xs)
    return jnp.moveaxis(o, 0, 2).reshape(B, H, T, dv), S


def trunk_layer(x, mod, w_in, conv_w, q_gain, k_gain, a_log, dt_bias, dn_gain, w_pa, w_pd, w_out,
                norm1, norm2, w1, b1, w2, b2, ctx, rope):
    B, T, _ = x.shape
    shift1, scale1, gate1, shift2, scale2, gate2 = jnp.split(mod.astype(x.dtype), 6, axis=-1)
    h = rmsnorm(x, norm1) * (1 + scale1) + shift1
    split_idx = [int(i) for i in np.cumsum(SPLIT_SIZES)[:-1]]
    (q_a, k_a, v_a, q_d, k_d, v_d, g_out, a_in, beta_in, gate_a, gate_d) = jnp.split(
        h @ w_in, split_idx, axis=-1)
    q_a = rmsnorm(q_a.reshape(B, T, N_Q_HEADS, HEAD_DIM), q_gain).transpose(0, 2, 1, 3)
    k_a = rmsnorm(k_a.reshape(B, T, N_KV_HEADS, HEAD_DIM), k_gain).transpose(0, 2, 1, 3)
    v_a = v_a.reshape(B, T, N_KV_HEADS, HEAD_DIM).transpose(0, 2, 1, 3)
    qkv_d = short_conv(jnp.concatenate([q_d, k_d, v_d], axis=-1), conv_w)
    q_d, k_d, v_d = jnp.split(qkv_d, [DN_K_WIDTH, 2 * DN_K_WIDTH], axis=-1)
    q_d = (l2norm(q_d.reshape(B, T, N_DN_HEADS, DK)) * (DK ** -0.5)).transpose(0, 2, 1, 3)
    k_d = l2norm(k_d.reshape(B, T, N_DN_HEADS, DK)).transpose(0, 2, 1, 3)
    v_d = v_d.reshape(B, T, N_DN_HEADS, DV).astype(jnp.float32).transpose(0, 2, 1, 3)
    a_in = a_in.reshape(B, T, 2, N_DN_HEADS).astype(jnp.float32)
    log_a = (-jnp.exp(a_log.astype(jnp.float32)) *
             jax.nn.softplus(a_in + dt_bias.astype(jnp.float32))).transpose(0, 2, 3, 1)
    beta = jax.nn.sigmoid(beta_in.astype(jnp.float32)).reshape(B, T, 2, N_DN_HEADS).transpose(0, 2, 3, 1)

    if ctx is None:
        k_all, v_all = k_a, v_a
        s_f = jnp.zeros((B, N_DN_HEADS, DK, DV), jnp.float32)
        s_b = jnp.zeros((B, N_DN_HEADS, DK, DV), jnp.float32)
        q_use = q_a
    else:
        k_ctx, v_ctx, s_f, s_b = ctx
        cos, sin = rope
        q_use = apply_rope(q_a, cos, sin)
        k_all = jnp.concatenate([k_ctx.astype(x.dtype), apply_rope(k_a, cos, sin)], axis=2)
        v_all = jnp.concatenate([v_ctx.astype(x.dtype), v_a], axis=2)
        s_f = s_f.astype(jnp.float32)
        s_b = s_b.astype(jnp.float32)

    o_a = block_attention(q_use.reshape(B, N_KV_HEADS, N_GROUPS, T, HEAD_DIM), k_all, v_all)
    o_a = o_a.transpose(0, 2, 1, 3).reshape(B, T, ATTN_WIDTH)

    o_f, S_f = delta_chunked(q_d, k_d, v_d, log_a[:, 0], beta[:, 0], s_f)
    o_b, S_b = delta_chunked(jnp.flip(q_d, 2), jnp.flip(k_d, 2), jnp.flip(v_d, 2),
                             jnp.flip(log_a[:, 1], -1), jnp.flip(beta[:, 1], -1), s_b)
    o_d = (o_f + jnp.flip(o_b, 2)).transpose(0, 2, 1, 3)
    o_d = rmsnorm(o_d, dn_gain) * jax.nn.silu(g_out.reshape(B, T, N_DN_HEADS, DV).astype(jnp.float32))
    o_d = o_d.reshape(B, T, DN_V_WIDTH).astype(x.dtype)

    merged = jax.nn.sigmoid(gate_a) * (o_a @ w_pa) + jax.nn.sigmoid(gate_d) * (o_d @ w_pd)
    x = x + gate1 * (merged @ w_out)
    h2 = rmsnorm(x, norm2) * (1 + scale2) + shift2
    ff = jnp.square(jax.nn.relu(h2 @ w1 + b1)) @ w2 + b2
    x = x + gate2 * ff
    return x, k_a, v_a, S_f, S_b


def setup_inputs(seed: int = 0) -> dict:
    key = jax.random.key(seed)
    ks = jax.random.split(key, 32)

    def nrm(k, shape, scale):
        return jax.random.normal(k, shape, jnp.float32) * scale

    dt = jnp.exp(jax.random.uniform(ks[14], (DEPTH, 2, N_DN_HEADS), jnp.float32,
                                    float(np.log(1e-3)), float(np.log(1e-1))))
    return {
        'x_prompt': nrm(ks[0], (BATCH, SEQ, D_MODEL), 1.0),
        'x_sample': nrm(ks[1], (DEC_BATCH, DEC_SEQ, D_MODEL), 1.0),
        'c': nrm(ks[2], (DEC_BATCH, D_MODEL), 1.0),
        'cache_k': nrm(ks[3], (DEC_BATCH, DEPTH, N_KV_HEADS, PAST_LEN, HEAD_DIM), 1.0),
        'cache_v': nrm(ks[4], (DEC_BATCH, DEPTH, N_KV_HEADS, PAST_LEN, HEAD_DIM), 1.0),
        'state_delta': nrm(ks[5], (DEC_BATCH, DEPTH, 2, N_DN_HEADS, DK, DV), 0.1),
        'c_ctx': nrm(ks[6], (D_MODEL,), 1.0),
        'w_mod': nrm(ks[7], (DEPTH, D_MODEL, 6 * D_MODEL), 0.5 * D_MODEL ** -0.5),
        'b_mod': nrm(ks[8], (DEPTH, 6 * D_MODEL), 0.02),
        'norm1': 1.0 + nrm(ks[9], (DEPTH, D_MODEL), 0.02),
        'norm2': 1.0 + nrm(ks[10], (DEPTH, D_MODEL), 0.02),
        'w_in': nrm(ks[11], (DEPTH, D_MODEL, IN_WIDTH), D_MODEL ** -0.5),
        'conv_w': nrm(ks[12], (DEPTH, CONV_W, CONV_CH), CONV_W ** -0.5),
        'q_gain': 1.0 + nrm(ks[13], (DEPTH, HEAD_DIM), 0.02),
        'k_gain': 1.0 + nrm(ks[15], (DEPTH, HEAD_DIM), 0.02),
        'a_log': jnp.log(jax.random.uniform(ks[16], (DEPTH, 2, N_DN_HEADS), jnp.float32, 1.0, 16.0)),
        'dt_bias': dt + jnp.log(-jnp.expm1(-dt)),
        'dn_gain': 1.0 + nrm(ks[17], (DEPTH, DV), 0.02),
        'w_pa': nrm(ks[18], (DEPTH, ATTN_WIDTH, D_MODEL), ATTN_WIDTH ** -0.5),
        'w_pd': nrm(ks[19], (DEPTH, DN_V_WIDTH, D_MODEL), DN_V_WIDTH ** -0.5),
        'w_out': nrm(ks[20], (DEPTH, D_MODEL, D_MODEL), D_MODEL ** -0.5),
        'w1': nrm(ks[21], (DEPTH, D_MODEL, D_FF), D_MODEL ** -0.5),
        'b1': nrm(ks[22], (DEPTH, D_FF), 0.02),
        'w2': nrm(ks[23], (DEPTH, D_FF, D_MODEL), D_FF ** -0.5),
        'b2': nrm(ks[24], (DEPTH, D_MODEL), 0.02),
        'final_norm': 1.0 + nrm(ks[25], (D_MODEL,), 0.02),
    }


def reference(x_prompt, x_sample, c, cache_k, cache_v, state_delta, c_ctx, w_mod, b_mod, norm1, norm2,
              w_in, conv_w, q_gain, k_gain, a_log, dt_bias, dn_gain, w_pa, w_pd, w_out,
              w1, b1, w2, b2, final_norm):
    rope = axial_rope(x_sample.shape[1])
    xp, xs = x_prompt, x_sample
    ks_out, vs_out, st_out = [], [], []
    for l in range(DEPTH):
        lw = (w_in[l], conv_w[l], q_gain[l], k_gain[l], a_log[l], dt_bias[l], dn_gain[l],
              w_pa[l], w_pd[l], w_out[l], norm1[l], norm2[l], w1[l], b1[l], w2[l], b2[l])
        mod_ctx = adaln(c_ctx, w_mod[l], b_mod[l])[None, None, :]
        xp, k_c, v_c, s_fwd, s_bwd = trunk_layer(xp, mod_ctx, *lw, ctx=None, rope=None)
        ks_out.append(k_c)
        vs_out.append(v_c)
        st_out.append(jnp.stack([s_fwd, s_bwd], axis=1))
        mod_lat = adaln(c, w_mod[l], b_mod[l])[:, None, :]
        ctx = (cache_k[:, l], cache_v[:, l], state_delta[:, l, 0], state_delta[:, l, 1])
        xs, _, _, _, _ = trunk_layer(xs, mod_lat, *lw, ctx=ctx, rope=rope)
    y_prompt = rmsnorm(xp, final_norm)
    y_sample = rmsnorm(xs, final_norm)
    new_cache_k = jnp.stack(ks_out, axis=1)
    new_cache_v = jnp.stack(vs_out, axis=1)
    new_state_delta = jnp.stack(st_out, axis=1)
    return (y_prompt, y_sample, new_cache_k, new_cache_v, new_state_delta)
```

```cpp
#include <hip/hip_runtime.h>
#include <cstdio>
#include <cstdint>

#ifndef MK_ONE_LAUNCH
#define MK_ONE_LAUNCH 1
#endif

constexpr int D = 1024, NPB = 32, TP = 256, NSB = 4, TS = 4096, PAST = 256, DEPTH = 2;
constexpr int MP = NPB * TP, MS = NSB * TS, M = MP + MS;
constexpr int NQH = 8, NKVH = 2, HD = 64, NDH = 8;
constexpr int INW = 4896, NA = 2848, NA_PAD = 3072, NG = 2048, FF = 4096, CONVC = 1536;
constexpr int KEYS_S = PAST + TS;
constexpr float EPS = 1e-6f;
constexpr float C2 = 0.125f * 1.4426950408889634f;
constexpr int NWAVES = 8, NTHREADS = 512;

constexpr size_t MiB = 1u << 20;
constexpr size_t WS_CTL = 0, CTL_ZERO_BYTES = 1 * MiB;
constexpr size_t WS_MOD = 1 * MiB;
constexpr size_t WS_ROPE = 2 * MiB;
constexpr size_t WS_W = 3 * MiB;
constexpr size_t W_INA = 0, W_ING = 6 * MiB, W_P = 10 * MiB, W_OUT = 12 * MiB, W_1 = 14 * MiB, W_2 = 22 * MiB;
constexpr size_t WS_H = 33 * MiB;
constexpr size_t WS_QO = 81 * MiB;
constexpr size_t WS_R4 = 129 * MiB;
constexpr size_t WS_KP = WS_R4, WS_VP = WS_R4 + 2 * MiB, WS_KS = WS_R4 + 4 * MiB, WS_VS = WS_R4 + 9 * MiB;
constexpr size_t WS_LA = WS_R4 + 14 * MiB, WS_BETA = WS_R4 + 16 * MiB;
constexpr size_t WS_GOUT = WS_R4 + 18 * MiB;
constexpr size_t WS_CONV = WS_R4 + 42 * MiB;
constexpr size_t WS_BND = WS_R4 + 114 * MiB;
constexpr size_t WS_GATES = WS_R4;
constexpr size_t WS_FF = WS_R4;
constexpr size_t WS_END = 256 * MiB;
static_assert(WS_CONV + (size_t)M * CONVC * 2 <= WS_END && WS_GATES + (size_t)M * NG * 2 <= WS_END && WS_FF + (size_t)(M / 2) * FF * 2 <= WS_END, "ws map");

constexpr int CW_BAR = 4096;
constexpr size_t CTL_SUMSQ2 = 256 * 1024;
constexpr size_t WS_SB1 = WS_MOD + 512 * 1024;

#define GAS __attribute__((address_space(1)))
#define LAS __attribute__((address_space(3)))
typedef unsigned short bf16;
typedef unsigned v4u __attribute__((ext_vector_type(4)));
typedef unsigned v2u __attribute__((ext_vector_type(2)));
typedef float f32x4 __attribute__((ext_vector_type(4)));
#define RLX_AGENT __ATOMIC_RELAXED, __HIP_MEMORY_SCOPE_AGENT
__device__ __forceinline__ unsigned f2bf(float f) { unsigned u = __builtin_bit_cast(unsigned, f); return (u + 0x7fffu + ((u >> 16) & 1u)) >> 16; }
__device__ __forceinline__ unsigned pk2(float lo, float hi) { return f2bf(lo) | (f2bf(hi) << 16); }
__device__ __forceinline__ float bf2f(unsigned short b) { return __builtin_bit_cast(float, (unsigned)b << 16); }
__device__ __forceinline__ float bflo(unsigned w) { return __builtin_bit_cast(float, w << 16); }
__device__ __forceinline__ float bfhi(unsigned w) { return __builtin_bit_cast(float, w & 0xffff0000u); }
__device__ __forceinline__ float sigmoidf_(float x) { return 1.f / (1.f + __expf(-x)); }
__device__ __forceinline__ float siluf_(float x) { return x / (1.f + __expf(-x)); }
__device__ __forceinline__ float shx(float v, int mask, int lane) { return __builtin_bit_cast(float, __builtin_amdgcn_ds_bpermute((lane ^ mask) << 2, __builtin_bit_cast(int, v))); }
__device__ __forceinline__ float shl_from(float v, int src_lane) { return __builtin_bit_cast(float, __builtin_amdgcn_ds_bpermute((src_lane & 63) << 2, __builtin_bit_cast(int, v))); }
__device__ __forceinline__ float wave_sum(float v, int lane) {
#pragma unroll
    for (int o = 1; o < 64; o <<= 1) v += shx(v, o, lane);
    return v;
}

#define XB_TMO      128
#define XB_XCNT(j)  (256  + 64 * (j))
#define XB_XSUB(j)  (1280 + 64 * (j))
#define XB_XGEN(j)  (2304 + 64 * (j))
#define XB_TOP      3328
#define XB_TOPGEN   3392
#define XCD_BAR_WORDS 3456
#define XB_SPIN_CAP (1u << 25)
__device__ __forceinline__ unsigned xb_ld(unsigned* p)              { return __hip_atomic_load((GAS unsigned*)p, __ATOMIC_RELAXED, __HIP_MEMORY_SCOPE_AGENT); }
__device__ __forceinline__ unsigned xb_add(unsigned* p, unsigned v) { return __hip_atomic_fetch_add((GAS unsigned*)p, v, __ATOMIC_RELAXED, __HIP_MEMORY_SCOPE_AGENT); }
__device__ __forceinline__ unsigned xb_xcc_id() { return (unsigned)__builtin_amdgcn_s_getreg((3 << 11) | 20) & 0xFu; }
#define XB_SPIN(cond, bar) do { unsigned _sp = 0; while (cond) { __builtin_amdgcn_s_sleep(1); \
    if ((++_sp & 255u) == 0u) { if (xb_ld(&(bar)[XB_TMO])) break; if (_sp > XB_SPIN_CAP) { xb_add(&(bar)[XB_TMO], 1u); break; } } } } while (0)
struct XcdBarrier { unsigned* bar; unsigned x; volatile LAS unsigned* st; };
__device__ __forceinline__ XcdBarrier xcd_barrier_post(unsigned* bar, volatile LAS unsigned* st) {
    XcdBarrier b; b.bar = bar; b.x = xb_xcc_id(); b.st = st;
    if (threadIdx.x == 0) (void)xb_add(&bar[XB_XCNT(b.x)], 1u);
    return b;
}
__device__ __forceinline__ void xcd_barrier_complete(unsigned* bar, unsigned x, unsigned& nloc, unsigned& nx) {
    const unsigned G = gridDim.x * gridDim.y * gridDim.z;
    unsigned sum, cnt, mine, sp = 0u;
    for (;;) {
        sum = 0u; cnt = 0u; mine = 0u;
#pragma unroll
        for (unsigned j = 0; j < 16; ++j) { const unsigned c = xb_ld(&bar[XB_XCNT(j)]); sum += c; cnt += (c > 0u) ? 1u : 0u; mine = (j == x) ? c : mine; }
        if (sum == G) break;
        __builtin_amdgcn_s_sleep(1);
        if ((++sp & 255u) == 0u) { if (xb_ld(&bar[XB_TMO])) break; if (sp > XB_SPIN_CAP) { xb_add(&bar[XB_TMO], 1u); break; } }
    }
    nloc = mine > 0u ? mine : 1u; nx = cnt > 0u ? cnt : 1u;
}
__device__ __forceinline__ void xcd_barrier(const XcdBarrier& b_, const int tid) {
    asm volatile("s_waitcnt vmcnt(0)" ::: "memory");
    __syncthreads();
    if (tid == 0) {
        XcdBarrier b; b.st = b_.st; { unsigned* p = b_.bar; asm volatile("" : "+s"(p)); b.bar = p; } b.x = (unsigned)__builtin_amdgcn_readfirstlane((int)xb_xcc_id());
        unsigned* bar = b.bar;
        __builtin_amdgcn_s_waitcnt(0);
        unsigned nloc = b.st[0], nx = b.st[1];
        if (nloc == 0u) { xcd_barrier_complete(bar, b.x, nloc, nx); b.st[0] = nloc; b.st[1] = nx; }
        const unsigned old = xb_add(&bar[XB_XSUB(b.x)], 1u);
        const unsigned gen = old / nloc;
        if (old + 1u == (gen + 1u) * nloc) {
            __builtin_amdgcn_fence(__ATOMIC_RELEASE, "agent");
            asm volatile("s_waitcnt vmcnt(0)" ::: "memory");
            const unsigned og = xb_add(&bar[XB_TOP], 1u);
            const unsigned tg = og / nx;
            if (og + 1u == (tg + 1u) * nx) xb_add(&bar[XB_TOPGEN], 1u);
            else XB_SPIN(xb_ld(&bar[XB_TOPGEN]) == tg, bar);
            __builtin_amdgcn_fence(__ATOMIC_ACQUIRE, "agent");
            xb_add(&bar[XB_XGEN(b.x)], 1u);
            asm volatile("s_waitcnt vmcnt(0)" ::: "memory");
        } else {
            XB_SPIN(xb_ld(&bar[XB_XGEN(b.x)]) == gen, bar);
            __builtin_amdgcn_fence(__ATOMIC_ACQUIRE, "agent");
            asm volatile("s_waitcnt vmcnt(0)" ::: "memory");
        }
    }
    __syncthreads();
}

constexpr int LDS_BYTES = 147456;
constexpr int MISC_OFF = 131072 + 320;
struct Args { const float* in[26]; float* out; unsigned char* ws; int ph_lo, ph_hi; };
struct Frame {
    LAS unsigned char* lds;
    int tid, lane, wave, G, bid;
    const float* const* in; float* out; unsigned char* ws;
};
__device__ __forceinline__ int mod_index(int row) { return row < MP ? 0 : 1 + (row - MP) / TS; }
__device__ __forceinline__ const float* mod_ptr(const Frame& F, int l, int row, int part) { return (const float*)(F.ws + WS_MOD) + ((size_t)(l * 5 + mod_index(row)) * 6 + part) * D; }

__device__ __forceinline__ void transpose_item(const float* W, int ldw, int c0, int ncols, int K, bf16* WT, int row_off, LAS float* scr, int item, int lane) {
    const int nblk = ncols / 32, kb = item / nblk, nb = item % nblk, k0 = 64 * kb, n0 = 32 * nb;
#pragma unroll 8
    for (int i = 0; i < 32; ++i) { const int kk = 2 * i + (lane >> 5); scr[kk * 33 + (lane & 31)] = W[(size_t)(k0 + kk) * ldw + c0 + n0 + (lane & 31)]; }
    asm volatile("s_waitcnt lgkmcnt(0)" ::: "memory");
    const int c = lane & 7;
#pragma unroll
    for (int j = 0; j < 4; ++j) { const int n = (lane >> 3) + 8 * j; const LAS float* s = scr + (8 * c) * 33 + n;
        v4u o; o.x = pk2(s[0 * 33], s[1 * 33]); o.y = pk2(s[2 * 33], s[3 * 33]); o.z = pk2(s[4 * 33], s[5 * 33]); o.w = pk2(s[6 * 33], s[7 * 33]);
        *(GAS v4u*)(WT + (size_t)(row_off + n0 + n) * K + k0 + 8 * c) = o; }
    asm volatile("s_waitcnt lgkmcnt(0)" ::: "memory");
}
__device__ __forceinline__ void ph_convert_weights(Frame& F, int l) {
    LAS float* scr = (LAS float*)(F.lds + F.wave * 16384);
    const int gw = F.bid * NWAVES + F.wave, NGW = F.G * NWAVES;
    unsigned char* wb = F.ws + WS_W;
    const float* w_in = F.in[11] + (size_t)l * D * INW; const float* w_pa = F.in[18] + (size_t)l * 512 * D; const float* w_pd = F.in[19] + (size_t)l * 512 * D;
    const float* w_out = F.in[20] + (size_t)l * D * D; const float* w1 = F.in[21] + (size_t)l * D * FF; const float* w2 = F.in[23] + (size_t)l * FF * D;
    constexpr int I_A = (D / 64) * (NA / 32), I_G = (D / 64) * (NG / 32), I_P = (512 / 64) * (D / 32), I_O = (D / 64) * (D / 32), I_1 = (D / 64) * (FF / 32), I_2 = (FF / 64) * (D / 32);
    constexpr int NITEMS = I_A + I_G + 2 * I_P + I_O + I_1 + I_2;
    for (int it = gw; it < NITEMS; it += NGW) {
        int r = it; const float* W; int ldw, c0, ncols, K; bf16* WT;
        if (r < I_A) { W = w_in; ldw = INW; c0 = 0; ncols = NA; K = D; WT = (bf16*)(wb + W_INA); }
        else if ((r -= I_A) < I_G) { W = w_in; ldw = INW; c0 = NA; ncols = NG; K = D; WT = (bf16*)(wb + W_ING); }
        else if ((r -= I_G) < I_P) { W = w_pa; ldw = D; c0 = 0; ncols = D; K = 512; WT = (bf16*)(wb + W_P); }
        else if ((r -= I_P) < I_P) { W = w_pd; ldw = D; c0 = 0; ncols = D; K = 512; WT = (bf16*)(wb + W_P) + (size_t)D * 512; }
        else if ((r -= I_P) < I_O) { W = w_out; ldw = D; c0 = 0; ncols = D; K = D; WT = (bf16*)(wb + W_OUT); }
        else if ((r -= I_O) < I_1) { W = w1; ldw = FF; c0 = 0; ncols = FF; K = D; WT = (bf16*)(wb + W_1); }
        else { r -= I_1; W = w2; ldw = D; c0 = 0; ncols = D; K = FF; WT = (bf16*)(wb + W_2); }
        transpose_item(W, ldw, c0, ncols, K, WT, 0, scr, r, F.lane);
    }
    { v4u* p = (v4u*)((bf16*)(wb + W_INA) + (size_t)NA * D); const int n16 = (NA_PAD - NA) * D * 2 / 16;
      unsigned zz = 0u; asm volatile("" : "+v"(zz));
      for (int i = F.bid * NTHREADS + F.tid; i < n16; i += F.G * NTHREADS) p[i] = (v4u){zz, zz, zz, zz}; }
    { const float* ck = F.in[3]; const float* cv = F.in[4]; bf16* KS = (bf16*)(F.ws + WS_KS); bf16* VS = (bf16*)(F.ws + WS_VS);
      const int n = NSB * PAST * 128;
      for (int i = F.bid * NTHREADS + F.tid; i < n; i += F.G * NTHREADS) { const int d = i & 63, kvh = (i >> 6) & 1, j = (i >> 7) & 255, b = i >> 15;
          const size_t src = ((((size_t)b * DEPTH + l) * NKVH + kvh) * PAST + j) * HD + d; const size_t dst = ((size_t)b * KEYS_S + j) * 128 + kvh * 64 + d;
          KS[dst] = (bf16)f2bf(ck[src]); VS[dst] = (bf16)f2bf(cv[src]); } }
}
__device__ __forceinline__ void ph_prologue(Frame& F) {
    { float* rc = (float*)(F.ws + WS_ROPE); float* rs = rc + TS * 32;
      for (int i = F.bid * NTHREADS + F.tid; i < TS * 32; i += F.G * NTHREADS) { const int t = i >> 5, f = i & 31;
          const float inv = powf(10000.0f, -(float)(f & 15) / 16.0f); const float pos = (f < 16) ? (float)(t >> 6) : (float)(t & 63); const float ang = pos * inv;
          rc[i] = cosf(ang); rs[i] = sinf(ang); } }
    { LAS float* sc = (LAS float*)F.lds;
      LAS float* red = sc + 5 * D;
      for (int i = F.tid; i < 5 * D; i += NTHREADS) { const int j = i / D, k = i % D; const float v = j == 0 ? F.in[6][k] : F.in[2][(j - 1) * D + k]; sc[i] = siluf_(v); }
      __syncthreads();
      for (int it = F.bid; it < DEPTH * 96; it += F.G) { const int l = it / 96, n0 = (it % 96) * 64;
          const float* w = F.in[7] + (size_t)l * D * 6144 + n0 + F.lane; float acc[5] = {0.f, 0.f, 0.f, 0.f, 0.f};
          for (int k = F.wave * 128; k < F.wave * 128 + 128; ++k) { const float wv = w[(size_t)k * 6144];
#pragma unroll
              for (int j = 0; j < 5; ++j) acc[j] += sc[j * D + k] * wv; }
#pragma unroll
          for (int j = 0; j < 5; ++j) red[(F.wave * 5 + j) * 64 + F.lane] = acc[j];
          __syncthreads();
          if (F.tid < 320) { const int j = F.tid / 64, n = F.tid % 64; float s = F.in[8][l * 6144 + n0 + n];
              for (int w8 = 0; w8 < 8; ++w8) s += red[(w8 * 5 + j) * 64 + n];
              ((float*)(F.ws + WS_MOD))[(size_t)(l * 5 + j) * 6144 + n0 + n] = s; }
          __syncthreads(); } }
}
__device__ __forceinline__ void ph_modnorm(Frame& F, int l, int which  , bool from_inputs) {
    const float* g = F.in[which ? 10 : 9] + l * D; bf16* H = (bf16*)(F.ws + WS_H);
    const int gw = F.bid * NWAVES + F.wave, NGW = F.G * NWAVES;
    for (int m = gw; m < M; m += NGW) {
        const float* xrow = from_inputs ? (m < MP ? F.in[0] + (size_t)m * D : F.in[1] + (size_t)(m - MP) * D) : F.out + (size_t)m * D;
        const f32x4* xr = (const f32x4*)xrow + F.lane;
        const f32x4* sh = (const f32x4*)mod_ptr(F, l, m, which ? 3 : 0) + F.lane; const f32x4* scp = (const f32x4*)mod_ptr(F, l, m, which ? 4 : 1) + F.lane; const f32x4* gp = (const f32x4*)g + F.lane;
        f32x4 v[4]; float s = 0.f;
#pragma unroll
        for (int j = 0; j < 4; ++j) { v[j] = xr[64 * j]; s += (v[j].x * v[j].x + v[j].y * v[j].y) + (v[j].z * v[j].z + v[j].w * v[j].w); }
        const float rstd = 1.f / sqrtf(wave_sum(s, F.lane) * (1.f / D) + EPS);
        v2u* o8 = (v2u*)(H + (size_t)m * D) + F.lane;
#pragma unroll
        for (int j = 0; j < 4; ++j) { const f32x4 gg = gp[64 * j], s1 = scp[64 * j], s0 = sh[64 * j]; const f32x4 y = v[j] * rstd * gg * (s1 + 1.f) + s0;
            v2u w; w.x = pk2(y.x, y.y); w.y = pk2(y.z, y.w); o8[64 * j] = w; }
    }
}
__device__ __forceinline__ void ph_final_norm(Frame& F) {
    const float* g = F.in[25]; const int gw = F.bid * NWAVES + F.wave, NGW = F.G * NWAVES;
    for (int m = gw; m < M; m += NGW) {
        f32x4* xr = (f32x4*)(F.out + (size_t)m * D) + F.lane; const f32x4* gp = (const f32x4*)g + F.lane;
        f32x4 v[4]; float s = 0.f;
#pragma unroll
        for (int j = 0; j < 4; ++j) { v[j] = xr[64 * j]; s += (v[j].x * v[j].x + v[j].y * v[j].y) + (v[j].z * v[j].z + v[j].w * v[j].w); }
        const float rstd = 1.f / sqrtf(wave_sum(s, F.lane) * (1.f / D) + EPS);
#pragma unroll
        for (int j = 0; j < 4; ++j) xr[64 * j] = v[j] * rstd * gp[64 * j];
    }
}

namespace pg8 {
#define PG8_LAS __attribute__((address_space(3)))
typedef unsigned short bf16_t;
typedef short bf16x8 __attribute__((ext_vector_type(8)));
typedef unsigned u32x4 __attribute__((ext_vector_type(4)));
constexpr int BM = 256, BK = 64, HALF = 128, HTB = HALF * BK * 2, NXCD = 8, WGM = 8;
__host__ __device__ __forceinline__ int lds_byte(int r, int c) { const int st = (r >> 4) * 2 + (c >> 5), rr = r & 15, cc = c & 31, ob = rr * 64 + cc * 2; return st * 1024 + (ob ^ (((ob >> 9) & 1) << 5)); }
__host__ __device__ __forceinline__ void stage_rc(int b, int& R, int& C) { const int st = b / 1024, sb = b % 1024, swz = sb ^ (((sb >> 9) & 1) << 5); R = (st >> 1) * 16 + swz / 64; C = (st & 1) * 32 + (swz % 64) / 2; }
__host__ __device__ __forceinline__ int perm32(int rho) { const int n = rho >> 4, i = rho & 15; return 8 * (i >> 2) + 4 * n + (i & 3); }
struct Unit { int pm, pn, part; const char* a; const char* b; };
struct Shape { int lda, ldb, nt; };
struct TileOrder {
    int nM, nN, nwg, G, c; const char* A; const char* B; size_t at, bt;
    __device__ void init(int nM_, int nN_, int G_, int c_, const void* A_, size_t at_, const void* B_, size_t bt_) { nM = nM_; nN = nN_; nwg = nM * nN; G = G_; c = c_; A = (const char*)A_; B = (const char*)B_; at = at_; bt = bt_; }
    __device__ bool tile(int i, int& pm, int& pn) const {
        const long L = (long)i * G + c; if (L >= nwg) return false;
        int wgid = (int)L; { const int q = nwg / NXCD, r = nwg % NXCD, xcd = wgid % NXCD, off = wgid / NXCD; wgid = (xcd < r ? xcd * (q + 1) : r * (q + 1) + (xcd - r) * q) + off; }
        const int nig = WGM * nN, gid = wgid / nig, fm = gid * WGM, gsz = (nM - fm) < WGM ? (nM - fm) : WGM;
        pm = fm + ((wgid % nig) % gsz); pn = (wgid % nig) / gsz; return true;
    }
    __device__ bool next(int i, Unit& u) const { if (!tile(i, u.pm, u.pn)) return false; u.part = 1; u.a = A + (size_t)u.pm * at; u.b = B + (size_t)u.pn * bt; return true; }
};
struct TwoPartOrder : TileOrder {
    const char* B1; size_t apart;
    __device__ bool next(int i, Unit& u) const { if (!tile(i >> 1, u.pm, u.pn)) return false; u.part = i & 1; u.a = A + (size_t)u.pm * at + (u.part ? apart : 0); u.b = (u.part ? B1 : B) + (size_t)u.pn * bt; return true; }
};
typedef float f32x2_t __attribute__((ext_vector_type(2))); typedef __bf16 bf16x2_t __attribute__((ext_vector_type(2)));
__device__ __forceinline__ unsigned cvt_pk_bf16(float lo, float hi) { f32x2_t v = {lo, hi}; bf16x2_t b = __builtin_convertvector(v, bf16x2_t); return __builtin_bit_cast(unsigned, b); }
__device__ __forceinline__ u32x4 pack8(const f32x4& a, const f32x4& b) { u32x4 w; w.x = cvt_pk_bf16(a[0], a[1]); w.y = cvt_pk_bf16(a[2], a[3]); w.z = cvt_pk_bf16(b[0], b[1]); w.w = cvt_pk_bf16(b[2], b[3]); return w; }
__device__ __forceinline__ void unpack8(const u32x4 w, f32x4& a, f32x4& b) { a = (f32x4){bflo(w.x), bfhi(w.x), bflo(w.y), bfhi(w.y)}; b = (f32x4){bflo(w.z), bfhi(w.z), bflo(w.w), bfhi(w.w)}; }
__device__ __forceinline__ float fsig(float x) { return __builtin_amdgcn_rcpf(1.f + __builtin_amdgcn_exp2f(-1.4426950408889634f * x)); }
__device__ __forceinline__ f32x4 fsig4(const f32x4& x) { return (f32x4){fsig(x[0]), fsig(x[1]), fsig(x[2]), fsig(x[3])}; }

struct EpiGates { static constexpr int BMAP = 1; static constexpr bool STAGGER = true; bf16_t* O;
    __device__ __forceinline__ void operator()(f32x4 (&acc)[2][2][4][2], const Unit& u, int wr, int wc, int fr, int fq) const {
        bf16_t* base = O + (size_t)(u.pm * BM + wr * 64 + fr) * NG + u.pn * BM + wc * 32 + 8 * fq;
#pragma unroll
        for (int ai = 0; ai < 2; ++ai)
#pragma unroll
            for (int m = 0; m < 4; ++m)
#pragma unroll
                for (int bj = 0; bj < 2; ++bj) *(GAS u32x4*)(base + (size_t)(ai * HALF + m * 16) * NG + bj * HALF) = pack8(fsig4(acc[ai][bj][m][0]), fsig4(acc[ai][bj][m][1]));
    }
};
struct EpiFfn1 { static constexpr int BMAP = 1; static constexpr bool STAGGER = true; bf16_t* O; const float* sb1; const float* sumsq; int row_off;
    __device__ __forceinline__ void operator()(f32x4 (&acc)[2][2][4][2], const Unit& u, int wr, int wc, int fr, int fq) const {
        const int col0 = u.pn * BM + wc * 32 + 8 * fq, rowt = row_off + u.pm * BM; bf16_t* base = O + (size_t)(u.pm * BM + wr * 64 + fr) * FF + col0;
        const float* bp = sb1 + (size_t)mod_index(rowt) * FF + col0;
        f32x4 bv[2][2];
#pragma unroll
        for (int bj = 0; bj < 2; ++bj)
#pragma unroll
            for (int n = 0; n < 2; ++n) bv[bj][n] = *(const GAS f32x4*)(bp + bj * HALF + 4 * n);
        float ssq[8];
#pragma unroll
        for (int i = 0; i < 8; ++i) ssq[i] = *(const GAS float*)(sumsq + rowt + (i >> 2) * HALF + wr * 64 + (i & 3) * 16 + fr);
#pragma unroll
        for (int ai = 0; ai < 2; ++ai)
#pragma unroll
            for (int m = 0; m < 4; ++m) { const float rstd = __builtin_amdgcn_rsqf(ssq[ai * 4 + m] * (1.f / D) + EPS);
#pragma unroll
                for (int bj = 0; bj < 2; ++bj) { f32x4 v0 = acc[ai][bj][m][0] * rstd + bv[bj][0], v1 = acc[ai][bj][m][1] * rstd + bv[bj][1];
                    v0 = __builtin_elementwise_max(v0, (f32x4){0.f, 0.f, 0.f, 0.f}); v1 = __builtin_elementwise_max(v1, (f32x4){0.f, 0.f, 0.f, 0.f});
                    *(GAS u32x4*)(base + (size_t)(ai * HALF + m * 16) * FF + bj * HALF) = pack8(v0 * v0, v1 * v1); } }
    }
};
struct EpiResid { static constexpr int BMAP = 0; static constexpr bool STAGGER = false; float* X; const float* bias; const float* modl; int gate_part, row_off; const float* xp; const float* xs;
    __device__ __forceinline__ void operator()(f32x4 (&acc)[2][2][4][2], const Unit& u, int wr, int wc, int fr, int fq) const {
        const int col0 = u.pn * BM + wc * 32 + 4 * fq, rowt = row_off + u.pm * BM;
        const float* gp = modl + ((size_t)mod_index(rowt) * 6 + gate_part) * D + col0;
        f32x4 gv[2][2], bv[2][2];
#pragma unroll
        for (int bj = 0; bj < 2; ++bj)
#pragma unroll
            for (int n = 0; n < 2; ++n) { gv[bj][n] = *(const GAS f32x4*)(gp + bj * HALF + n * 16); bv[bj][n] = bias ? *(const GAS f32x4*)(bias + col0 + bj * HALF + n * 16) : (f32x4){0.f, 0.f, 0.f, 0.f}; }
#pragma unroll
        for (int q = 0; q < 4; ++q) { const int ai = q >> 1, m0 = (q & 1) * 2; f32x4 xv[2][2][2];
#pragma unroll
            for (int mm = 0; mm < 2; ++mm) { const size_t ro = (size_t)(rowt + ai * HALF + wr * 64 + (m0 + mm) * 16 + fr) * D + col0; const float* xi = xp ? (rowt < MP ? xp + ro : xs + (ro - (size_t)MP * D)) : X + ro;
#pragma unroll
                for (int bj = 0; bj < 2; ++bj)
#pragma unroll
                    for (int n = 0; n < 2; ++n) xv[mm][bj][n] = *(const GAS f32x4*)(xi + bj * HALF + n * 16); }
#pragma unroll
            for (int mm = 0; mm < 2; ++mm) { float* xr = X + (size_t)(rowt + ai * HALF + wr * 64 + (m0 + mm) * 16 + fr) * D + col0;
#pragma unroll
                for (int bj = 0; bj < 2; ++bj)
#pragma unroll
                    for (int n = 0; n < 2; ++n) *(GAS f32x4*)(xr + bj * HALF + n * 16) = xv[mm][bj][n] + gv[bj][n] * (acc[ai][bj][m0 + mm][n] + bv[bj][n]); }
            asm volatile("" ::: "memory"); }
    }
};
struct EpiResidN2 { static constexpr int BMAP = 1; static constexpr bool STAGGER = false; float* X; const float* modl; const float* norm2; bf16_t* A2; float* sumsq; const float* xp; const float* xs;
    __device__ __forceinline__ void operator()(f32x4 (&acc)[2][2][4][2], const Unit& u, int wr, int wc, int fr, int fq) const {
        const int col0 = u.pn * BM + wc * 32 + 8 * fq, rowt = u.pm * BM;
        const float* mp = modl + (size_t)mod_index(rowt) * 6 * D + col0;
        f32x4 gv[2][2], sv[2][2];
#pragma unroll
        for (int bj = 0; bj < 2; ++bj)
#pragma unroll
            for (int n = 0; n < 2; ++n) { gv[bj][n] = *(const GAS f32x4*)(mp + 2 * D + bj * HALF + 4 * n); sv[bj][n] = *(const GAS f32x4*)(norm2 + col0 + bj * HALF + 4 * n) * (*(const GAS f32x4*)(mp + 4 * D + bj * HALF + 4 * n) + 1.f); }
#pragma unroll
        for (int q = 0; q < 4; ++q) { const int ai = q >> 1, m0 = (q & 1) * 2; f32x4 xv[2][2][2];
#pragma unroll
            for (int mm = 0; mm < 2; ++mm) { const size_t ro = (size_t)(rowt + ai * HALF + wr * 64 + (m0 + mm) * 16 + fr) * D + col0; const float* xi = xp ? (rowt < MP ? xp + ro : xs + (ro - (size_t)MP * D)) : X + ro;
#pragma unroll
                for (int bj = 0; bj < 2; ++bj) { xv[mm][bj][0] = *(const GAS f32x4*)(xi + bj * HALF); xv[mm][bj][1] = *(const GAS f32x4*)(xi + bj * HALF + 4); } }
            float ssv[2];
#pragma unroll
            for (int mm = 0; mm < 2; ++mm) { const int m = m0 + mm; const size_t ro = (size_t)(rowt + ai * HALF + wr * 64 + m * 16 + fr) * D + col0; float ss = 0.f;
#pragma unroll
                for (int bj = 0; bj < 2; ++bj) { const f32x4 x0 = xv[mm][bj][0] + gv[bj][0] * acc[ai][bj][m][0], x1 = xv[mm][bj][1] + gv[bj][1] * acc[ai][bj][m][1];
                    *(GAS f32x4*)(X + ro + bj * HALF) = x0; *(GAS f32x4*)(X + ro + bj * HALF + 4) = x1;
                    ss += (x0[0] * x0[0] + x0[1] * x0[1]) + (x0[2] * x0[2] + x0[3] * x0[3]) + (x1[0] * x1[0] + x1[1] * x1[1]) + (x1[2] * x1[2] + x1[3] * x1[3]);
                    *(GAS u32x4*)(A2 + ro + bj * HALF) = pack8(x0 * sv[bj][0], x1 * sv[bj][1]); }
                { const int ln = fr + 16 * fq; ss += shx(ss, 16, ln); ss += shx(ss, 32, ln); } ssv[mm] = ss; }
            if (fq == 0) {
#pragma unroll
                for (int mm = 0; mm < 2; ++mm) (void)__hip_atomic_fetch_add((GAS float*)(sumsq + rowt + ai * HALF + wr * 64 + (m0 + mm) * 16 + fr), ssv[mm], __ATOMIC_RELAXED, __HIP_MEMORY_SCOPE_AGENT); }
            asm volatile("" ::: "memory"); }
    }
};
struct EpiMerge { static constexpr int BMAP = 1; static constexpr bool STAGGER = false; const bf16_t* GT; bf16_t* O;
    __device__ __forceinline__ void operator()(f32x4 (&acc)[2][2][4][2], const Unit& u, int wr, int wc, int fr, int fq) const {
        const int col0 = u.pn * BM + wc * 32 + 8 * fq; const size_t row0 = (size_t)(u.pm * BM + wr * 64 + fr);
        if (u.part == 0) {
#pragma unroll
            for (int ai = 0; ai < 2; ++ai)
#pragma unroll
                for (int m = 0; m < 4; ++m) { const bf16_t* g = GT + (row0 + ai * HALF + m * 16) * NG + col0;
#pragma unroll
                    for (int bj = 0; bj < 2; ++bj) { f32x4 a0, a1, d0, d1; unpack8(*(const GAS u32x4*)(g + bj * HALF), a0, a1); unpack8(*(const GAS u32x4*)(g + D + bj * HALF), d0, d1);
#pragma unroll
                        for (int j = 0; j < 4; ++j) { acc[ai][bj][m][0][j] *= a0[j] * __builtin_amdgcn_rcpf(d0[j]); acc[ai][bj][m][1][j] *= a1[j] * __builtin_amdgcn_rcpf(d1[j]); } }
                    if (m & 1) asm volatile("" ::: "memory"); }
        } else {
#pragma unroll
            for (int ai = 0; ai < 2; ++ai) { u32x4 gd[4][2];
#pragma unroll
                for (int m = 0; m < 4; ++m)
#pragma unroll
                    for (int bj = 0; bj < 2; ++bj) gd[m][bj] = *(const GAS u32x4*)(GT + (row0 + ai * HALF + m * 16) * NG + D + col0 + bj * HALF);
#pragma unroll
                for (int m = 0; m < 4; ++m) { bf16_t* o = O + (row0 + ai * HALF + m * 16) * D + col0;
#pragma unroll
                    for (int bj = 0; bj < 2; ++bj) { f32x4 d0, d1; unpack8(gd[m][bj], d0, d1); *(GAS u32x4*)(o + bj * HALF) = pack8(acc[ai][bj][m][0] * d0, acc[ai][bj][m][1] * d1); } }
                asm volatile("" ::: "memory"); }
        }
    }
};
struct EpiProjA { static constexpr int BMAP = 2; static constexpr bool STAGGER = true;
    int l; unsigned char* ws; float* out; const float* const* in;
    __device__ __forceinline__ void operator()(f32x4 (&acc)[2][2][4][2], const Unit& u, int wr, int wc, int fr, int fq) const {
        bf16_t* const QO = (bf16_t*)(ws + WS_QO); bf16_t* const KP = (bf16_t*)(ws + WS_KP); bf16_t* const VP = (bf16_t*)(ws + WS_VP); bf16_t* const KS = (bf16_t*)(ws + WS_KS); bf16_t* const VS = (bf16_t*)(ws + WS_VS);
        bf16_t* const CONV = (bf16_t*)(ws + WS_CONV); bf16_t* const GOUT = (bf16_t*)(ws + WS_GOUT); float* const LA = (float*)(ws + WS_LA); float* const BETA = (float*)(ws + WS_BETA);
        float* const nck = out + (size_t)M * D; float* const ncv = nck + (size_t)NPB * DEPTH * NKVH * TP * HD; const float* const rc = (const float*)(ws + WS_ROPE); const float* const rs = rc + TS * 32;
        const int pn = u.pn, rowt = u.pm * BM; const bool samp = rowt >= MP;
        const int b = samp ? (rowt - MP) / TS : rowt / TP, t0 = samp ? (rowt - MP) % TS : 0;
        const int rl0 = wr * 64 + fr;
        if (pn <= 2) {
            const bool is_q = pn < 2, is_v = (pn == 2 && wc >= 2); const int hh = is_q ? 4 * pn + wc : (wc & 1);
            f32x4 g[2][2];
            if (!is_v) { const float* gp = in[is_q ? 13 : 14] + l * 64 + 8 * fq;
#pragma unroll
                for (int bj = 0; bj < 2; ++bj)
#pragma unroll
                    for (int n = 0; n < 2; ++n) g[bj][n] = *(const GAS f32x4*)(gp + 32 * bj + 4 * n); }
#pragma unroll
            for (int ai = 0; ai < 2; ++ai)
#pragma unroll
                for (int m = 0; m < 4; ++m) { const int rl = rl0 + ai * HALF + m * 16, t = t0 + rl; const size_t row = (size_t)rowt + rl;
                    f32x4 x[2][2];
#pragma unroll
                    for (int bj = 0; bj < 2; ++bj)
#pragma unroll
                        for (int n = 0; n < 2; ++n) x[bj][n] = acc[ai][bj][m][n];
                    if (!is_v) { float ss = 0.f;
#pragma unroll
                        for (int bj = 0; bj < 2; ++bj)
#pragma unroll
                            for (int n = 0; n < 2; ++n) ss += (x[bj][n][0] * x[bj][n][0] + x[bj][n][1] * x[bj][n][1]) + (x[bj][n][2] * x[bj][n][2] + x[bj][n][3] * x[bj][n][3]);
                        { const int ln = fr + 16 * fq; ss += shx(ss, 16, ln); ss += shx(ss, 32, ln); }
                        const float rstd = __builtin_amdgcn_rsqf(ss * (1.f / 64.f) + EPS);
#pragma unroll
                        for (int bj = 0; bj < 2; ++bj)
#pragma unroll
                            for (int n = 0; n < 2; ++n) x[bj][n] = x[bj][n] * rstd * g[bj][n]; }
                    if (!samp && !is_q) { float* dst = (is_v ? ncv : nck) + ((((size_t)b * DEPTH + l) * NKVH + hh) * TP + t) * HD + 8 * fq;
#pragma unroll
                        for (int bj = 0; bj < 2; ++bj)
#pragma unroll
                            for (int n = 0; n < 2; ++n) *(GAS f32x4*)(dst + 32 * bj + 4 * n) = x[bj][n]; }
                    if (samp && !is_v) {
#pragma unroll
                        for (int n = 0; n < 2; ++n) { const f32x4 c = *(const GAS f32x4*)(rc + t * 32 + 8 * fq + 4 * n), s_ = *(const GAS f32x4*)(rs + t * 32 + 8 * fq + 4 * n);
                            const f32x4 x1 = x[0][n], x2 = x[1][n]; x[0][n] = x1 * c - x2 * s_; x[1][n] = x2 * c + x1 * s_; } }
                    bf16_t* dst;
                    if (is_q) { dst = QO + row * D + hh * 64;
#pragma unroll
                        for (int bj = 0; bj < 2; ++bj)
#pragma unroll
                            for (int n = 0; n < 2; ++n) x[bj][n] = x[bj][n] * C2; }
                    else if (!is_v) dst = samp ? KS + ((size_t)b * KEYS_S + PAST + t) * 128 + hh * 64 : KP + row * 128 + hh * 64;
                    else dst = samp ? VS + ((size_t)b * KEYS_S + PAST + t) * 128 + hh * 64 : VP + row * 128 + hh * 64;
#pragma unroll
                    for (int bj = 0; bj < 2; ++bj) *(GAS u32x4*)(dst + 32 * bj + 8 * fq) = pack8(x[bj][0], x[bj][1]);
                    asm volatile("" ::: "memory");
                }
        } else if (pn <= 8) {
            bf16_t* base = CONV + ((size_t)rowt + rl0) * CONVC + (pn - 3) * BM + wc * 64 + 8 * fq;
#pragma unroll
            for (int ai = 0; ai < 2; ++ai)
#pragma unroll
                for (int m = 0; m < 4; ++m)
#pragma unroll
                    for (int bj = 0; bj < 2; ++bj) { const u32x4 w = pack8(acc[ai][bj][m][0], acc[ai][bj][m][1]); *(GAS u32x4*)(base + (size_t)(ai * HALF + m * 16) * CONVC + 32 * bj) = w;
                        if ((m == 0 && fr == 0) || (m == 3 && fr == 15)) {
                            const int rl = rl0 + ai * HALF + m * 16, ck = (rowt + rl) >> 6;
                            *(GAS u32x4*)((bf16_t*)(ws + WS_BND) + ((size_t)ck * 2 + (m == 3 ? 1 : 0)) * CONVC + (pn - 3) * BM + wc * 64 + 8 * fq + 32 * bj) = w; } }
        } else if (pn <= 10) {
            bf16_t* base = GOUT + ((size_t)rowt + rl0) * 512 + (pn - 9) * BM + wc * 64 + 8 * fq;
#pragma unroll
            for (int ai = 0; ai < 2; ++ai)
#pragma unroll
                for (int m = 0; m < 4; ++m)
#pragma unroll
                    for (int bj = 0; bj < 2; ++bj) { const f32x4 a = acc[ai][bj][m][0], c = acc[ai][bj][m][1]; *(GAS u32x4*)(base + (size_t)(ai * HALF + m * 16) * 512 + 32 * bj) = pack8(a * fsig4(a), c * fsig4(c)); }
        } else if (wc == 0) {
            const int idx0 = 8 * (fq & 1); const bool isb = fq >= 2;
#pragma unroll
            for (int ai = 0; ai < 2; ++ai)
#pragma unroll
                for (int m = 0; m < 4; ++m) { const size_t row = (size_t)rowt + rl0 + ai * HALF + m * 16;
#pragma unroll
                    for (int n = 0; n < 2; ++n) { const f32x4 v = acc[ai][0][m][n]; f32x4 o;
                        if (isb) o = fsig4(v);
                        else {
#pragma unroll
                            for (int j = 0; j < 4; ++j) { const int idx = idx0 + 4 * n + j; const float xx = v[j] + ((const GAS float*)in[16])[l * 16 + idx]; const float y = __expf(xx); const float sp = xx > 20.f ? xx : (y < 0.01f ? y * (1.f - y * (0.5f - 0.33333333f * y)) : __logf(1.f + y)); o[j] = -__expf(((const GAS float*)in[15])[l * 16 + idx]) * sp; } }
                        *(GAS f32x4*)((isb ? BETA : LA) + row * 16 + idx0 + 4 * n) = o; } }
        }
    }
};

template <class Epi, class Sched, bool ALIGN_EPI = true, bool SP2 = true>
__device__ __forceinline__ void gemm_phase(PG8_LAS unsigned char* lds, const Shape g, const Sched& S, const Epi& E, const int tid_in) {
    int tid = tid_in; asm volatile("" : "+v"(tid));
    const int wid = __builtin_amdgcn_readfirstlane(tid >> 6), lane = tid & 63, wr = wid >> 2, wc = wid & 3, fr = lane & 15, fq = lane >> 4;
    const int nt = g.nt;
    unsigned voffA[2], voffB[2];
#pragma unroll
    for (int i = 0; i < 2; ++i) { int R, C; stage_rc(tid * 16 + i * 8192, R, C);
        const int Rb = Epi::BMAP == 0 ? R : Epi::BMAP == 1 ? ((R & ~31) + perm32(R & 31)) : ((R >> 5) * 64 + perm32(R & 31));
        voffA[i] = (unsigned)(R * g.lda + C) * 2u; voffB[i] = (unsigned)(Rb * g.ldb + C) * 2u; }
    const size_t kstep = (size_t)(BK * 2);
    const size_t hstepA = (size_t)HALF * g.lda * 2, hstepB = (size_t)(Epi::BMAP == 2 ? 32 : HALF) * g.ldb * 2;
    const unsigned ldsw = (unsigned)wid * 1024u;
    const int aoff = lds_byte(wr * 64 + fr, fq * 8), boff = lds_byte(wc * 32 + fr, fq * 8);
#define PG8_SA(b, h) (((b) * 2 + (h)) * HTB)
#define PG8_SB(b, h) ((4 + (b) * 2 + (h)) * HTB)
#define PG8_STAGE(bufoff, gbase, voff) do { _Pragma("unroll") for (int _i = 0; _i < 2; ++_i) \
        __builtin_amdgcn_global_load_lds((const GAS unsigned*)((const char*)(gbase) + (voff)[_i]), (PG8_LAS unsigned*)(lds + (bufoff) + ldsw + _i * 8192), 16, 0, 0); } while (0)
#define PG8_LDA(dst, b, h) do { _Pragma("unroll") for (int m = 0; m < 4; ++m) _Pragma("unroll") for (int k = 0; k < 2; ++k) dst[m][k] = *(const PG8_LAS bf16x8*)(lds + PG8_SA(b, h) + aoff + m * 2048 + k * 1024); } while (0)
#define PG8_LDB(dst, b, h) do { _Pragma("unroll") for (int n = 0; n < 2; ++n) _Pragma("unroll") for (int k = 0; k < 2; ++k) dst[n][k] = *(const PG8_LAS bf16x8*)(lds + PG8_SB(b, h) + boff + n * 2048 + k * 1024); } while (0)
#define PG8_MMA(ai, bj, At, Bt) do { __builtin_amdgcn_s_setprio(1); _Pragma("unroll") for (int m = 0; m < 4; ++m) _Pragma("unroll") for (int n = 0; n < 2; ++n) _Pragma("unroll") for (int k = 0; k < 2; ++k) \
        acc[ai][bj][m][n] = __builtin_amdgcn_mfma_f32_16x16x32_bf16(Bt[n][k], At[m][k], acc[ai][bj][m][n], 0, 0, 0); __builtin_amdgcn_s_setprio(0); } while (0)
#define PG8_WAIT_V(n) asm volatile("s_waitcnt vmcnt(" #n ")" ::: "memory")
#define PG8_WAIT_L(n) asm volatile("s_waitcnt lgkmcnt(" #n ")" ::: "memory")
#define PG8_BAR __builtin_amdgcn_s_barrier()
#define PG8_SCHED __builtin_amdgcn_sched_barrier(0)
    Unit cur, nxt; int ui = 0;
    if (!S.next(0, cur)) return;
    if (Epi::STAGGER && (blockIdx.x & 8)) __builtin_amdgcn_s_sleep(127);
    f32x4 acc[2][2][4][2];
#define PG8_ZERO() do { _Pragma("unroll") for (int a = 0; a < 2; ++a) _Pragma("unroll") for (int b = 0; b < 2; ++b) _Pragma("unroll") for (int m = 0; m < 4; ++m) _Pragma("unroll") for (int n = 0; n < 2; ++n) acc[a][b][m][n] = (f32x4){0.f, 0.f, 0.f, 0.f}; } while (0)
    PG8_ZERO();
    bf16x8 At[4][2], B0[2][2], B1[2][2];
    const char* cA = cur.a; const char* cB = cur.b;
    if constexpr (SP2) {
        PG8_STAGE(PG8_SB(0, 0), cB, voffB); PG8_STAGE(PG8_SB(0, 1), cB + hstepB, voffB); PG8_STAGE(PG8_SA(0, 0), cA, voffA); PG8_STAGE(PG8_SA(0, 1), cA + hstepA, voffA);
        if (wr == 1) PG8_BAR;
        PG8_WAIT_V(2); PG8_BAR;
        PG8_STAGE(PG8_SB(1, 0), cB + kstep, voffB); PG8_STAGE(PG8_SA(1, 0), cA + kstep, voffA); PG8_STAGE(PG8_SB(1, 1), cB + hstepB + kstep, voffB);
        PG8_WAIT_V(6); PG8_BAR;
    } else {
        PG8_STAGE(PG8_SB(0, 0), cB, voffB); PG8_STAGE(PG8_SA(0, 0), cA, voffA); PG8_STAGE(PG8_SB(0, 1), cB + hstepB, voffB); PG8_STAGE(PG8_SA(0, 1), cA + hstepA, voffA);
        if (wr == 1) PG8_BAR;
        PG8_WAIT_V(4); PG8_BAR;
        PG8_STAGE(PG8_SB(1, 0), cB + kstep, voffB); PG8_STAGE(PG8_SA(1, 0), cA + kstep, voffA); PG8_STAGE(PG8_SB(1, 1), cB + hstepB + kstep, voffB);
        PG8_WAIT_V(6); PG8_BAR;
    }
    for (;;) {
        const bool has_next = S.next(ui + 1, nxt);
        const char* nA = has_next ? nxt.a : cA; const char* nB = has_next ? nxt.b : cB;
        for (int t = 0; t < nt; t += 2) {
            const bool last = (t == nt - 2);
            const char* a1 = cA + (size_t)(t + 1) * kstep;
            const char* a2 = last ? nA : cA + (size_t)(t + 2) * kstep; const char* b2 = last ? nB : cB + (size_t)(t + 2) * kstep;
            const char* a3 = a2 + kstep; const char* b3 = b2 + kstep;
            if constexpr (SP2) {
            PG8_LDB(B0, 0, 0); PG8_LDB(B1, 0, 1); PG8_SCHED; PG8_LDA(At, 0, 0); PG8_STAGE(PG8_SA(1, 1), a1 + hstepA, voffA);
            PG8_WAIT_V(8); PG8_WAIT_L(0); PG8_BAR; PG8_MMA(0, 0, At, B0); PG8_MMA(0, 1, At, B1); PG8_BAR; PG8_SCHED;
            PG8_LDA(At, 0, 1); PG8_STAGE(PG8_SB(0, 0), b2, voffB); PG8_STAGE(PG8_SB(0, 1), b2 + hstepB, voffB); PG8_STAGE(PG8_SA(0, 0), a2, voffA);
            PG8_WAIT_V(8); PG8_WAIT_L(0); PG8_BAR; PG8_MMA(1, 0, At, B0); PG8_MMA(1, 1, At, B1); PG8_BAR; PG8_SCHED;
            PG8_LDB(B0, 1, 0); PG8_LDB(B1, 1, 1); PG8_SCHED; PG8_LDA(At, 1, 0); PG8_STAGE(PG8_SA(0, 1), a2 + hstepA, voffA);
            PG8_WAIT_V(8); PG8_WAIT_L(0); PG8_BAR; PG8_MMA(0, 0, At, B0); PG8_MMA(0, 1, At, B1); PG8_BAR; PG8_SCHED;
            PG8_LDA(At, 1, 1); PG8_STAGE(PG8_SB(1, 0), b3, voffB); PG8_STAGE(PG8_SB(1, 1), b3 + hstepB, voffB); PG8_STAGE(PG8_SA(1, 0), a3, voffA);
            PG8_WAIT_V(8); PG8_WAIT_L(0); PG8_BAR; PG8_MMA(1, 0, At, B0); PG8_MMA(1, 1, At, B1); PG8_BAR; PG8_SCHED;
            } else {
            PG8_LDB(B0, 0, 0); PG8_SCHED; PG8_LDA(At, 0, 0); PG8_STAGE(PG8_SA(1, 1), a1 + hstepA, voffA);
            PG8_WAIT_L(8); PG8_BAR; PG8_WAIT_L(0); PG8_MMA(0, 0, At, B0); PG8_BAR; PG8_SCHED;
            PG8_LDB(B1, 0, 1); PG8_STAGE(PG8_SB(0, 0), b2, voffB);
            PG8_BAR; PG8_WAIT_L(0); PG8_MMA(0, 1, At, B1); PG8_BAR;
            PG8_LDA(At, 0, 1); PG8_STAGE(PG8_SA(0, 0), a2, voffA);
            PG8_BAR; PG8_WAIT_L(0); PG8_MMA(1, 0, At, B0); PG8_BAR; PG8_SCHED;
            PG8_STAGE(PG8_SB(0, 1), b2 + hstepB, voffB);
            PG8_WAIT_V(6); PG8_BAR; PG8_MMA(1, 1, At, B1); PG8_BAR;
            PG8_LDB(B0, 1, 0); PG8_SCHED; PG8_LDA(At, 1, 0); PG8_STAGE(PG8_SA(0, 1), a2 + hstepA, voffA);
            PG8_WAIT_L(8); PG8_BAR; PG8_WAIT_L(0); PG8_MMA(0, 0, At, B0); PG8_BAR; PG8_SCHED;
            PG8_LDB(B1, 1, 1); PG8_STAGE(PG8_SB(1, 0), b3, voffB);
            PG8_BAR; PG8_WAIT_L(0); PG8_MMA(0, 1, At, B1); PG8_BAR;
            PG8_LDA(At, 1, 1); PG8_STAGE(PG8_SA(1, 0), a3, voffA);
            PG8_BAR; PG8_WAIT_L(0); PG8_MMA(1, 0, At, B0); PG8_BAR; PG8_SCHED;
            PG8_STAGE(PG8_SB(1, 1), b3 + hstepB, voffB);
            PG8_WAIT_V(6); PG8_BAR; PG8_MMA(1, 1, At, B1); PG8_BAR;
            }
        }
        if constexpr (ALIGN_EPI) { if (wr == 0) PG8_BAR; }
        { int fr_ = fr, fq_ = fq; asm volatile("" : "+v"(fr_), "+v"(fq_)); E(acc, cur, wr, wc, fr_, fq_); }
        if (!has_next) break;
        if (cur.part != 0) PG8_ZERO();
        cur = nxt; cA = nA; cB = nB; ++ui;
        if constexpr (ALIGN_EPI) { if (wr == 1) PG8_BAR; }
    }
    PG8_WAIT_V(0);
    if constexpr (!ALIGN_EPI) { if (wr == 0) PG8_BAR; }
    PG8_BAR;
#undef PG8_SA
#undef PG8_SB
#undef PG8_STAGE
#undef PG8_LDA
#undef PG8_LDB
#undef PG8_MMA
#undef PG8_WAIT_V
#undef PG8_WAIT_L
#undef PG8_BAR
#undef PG8_SCHED
#undef PG8_ZERO
}
}

__device__ __forceinline__ void ph_projA(Frame& F, int l) {
    pg8::TileOrder S; S.init(M / 256, NA_PAD / 256, F.G, F.bid, F.ws + WS_H, (size_t)256 * D * 2, F.ws + WS_W + W_INA, (size_t)256 * D * 2);
    pg8::EpiProjA E; E.l = l; E.ws = F.ws; E.out = F.out; E.in = F.in;
    pg8::gemm_phase<pg8::EpiProjA, pg8::TileOrder>(F.lds, pg8::Shape{D, D, D / 64}, S, E, F.tid);
}
__device__ __forceinline__ void ph_gates(Frame& F) {
    pg8::TileOrder S; S.init(M / 256, NG / 256, F.G, F.bid, F.ws + WS_H, (size_t)256 * D * 2, F.ws + WS_W + W_ING, (size_t)256 * D * 2);
    pg8::EpiGates E{(bf16*)(F.ws + WS_GATES)};
    pg8::gemm_phase<pg8::EpiGates, pg8::TileOrder>(F.lds, pg8::Shape{D, D, D / 64}, S, E, F.tid);
}
__device__ __forceinline__ void ph_merge(Frame& F) {
    pg8::TwoPartOrder S; S.init(M / 256, D / 256, F.G, F.bid, F.ws + WS_QO, (size_t)256 * D * 2, F.ws + WS_W + W_P, (size_t)256 * 512 * 2);
    S.B1 = (const char*)(F.ws + WS_W + W_P) + (size_t)D * 512 * 2; S.apart = 512 * 2;
    pg8::EpiMerge E{(const bf16*)(F.ws + WS_GATES), (bf16*)(F.ws + WS_H)};
    pg8::gemm_phase<pg8::EpiMerge, pg8::TwoPartOrder>(F.lds, pg8::Shape{D, 512, 512 / 64}, S, E, F.tid);
}
__device__ __forceinline__ void ph_resid_gemm(Frame& F, int l, const void* A, int K, const void* Bt, const float* bias, int gate_part, int row_lo, int nrows, bool from_inputs) {
    pg8::TileOrder S; S.init(nrows / 256, D / 256, F.G, F.bid, A, (size_t)256 * K * 2, Bt, (size_t)256 * K * 2);
    pg8::EpiResid E{F.out, bias, (const float*)(F.ws + WS_MOD) + (size_t)l * 5 * 6144, gate_part, row_lo, from_inputs ? F.in[0] : nullptr, from_inputs ? F.in[1] : nullptr};
    pg8::gemm_phase<pg8::EpiResid, pg8::TileOrder>(F.lds, pg8::Shape{K, K, K / 64}, S, E, F.tid);
}
__device__ __forceinline__ void ph_outproj(Frame& F, int l, bool from_inputs) {
    pg8::TileOrder S; S.init(M / 256, D / 256, F.G, F.bid, F.ws + WS_H, (size_t)256 * D * 2, F.ws + WS_W + W_OUT, (size_t)256 * D * 2);
    pg8::EpiResidN2 E{F.out, (const float*)(F.ws + WS_MOD) + (size_t)l * 5 * 6144, F.in[10] + l * D, (bf16*)(F.ws + WS_QO), (float*)(F.ws + WS_CTL + CTL_SUMSQ2) + (size_t)l * M, from_inputs ? F.in[0] : nullptr, from_inputs ? F.in[1] : nullptr};
    pg8::gemm_phase<pg8::EpiResidN2, pg8::TileOrder>(F.lds, pg8::Shape{D, D, D / 64}, S, E, F.tid);
}
__device__ __forceinline__ void ph_sb1(Frame& F) {
    LAS float* red = (LAS float*)F.lds;
    for (int it = F.bid; it < DEPTH * (FF / 64); it += F.G) { const int l = it / (FF / 64), n0 = (it % (FF / 64)) * 64;
        const float* w = F.in[21] + (size_t)l * D * FF + n0 + F.lane; const float* sh = (const float*)(F.ws + WS_MOD) + (size_t)l * 5 * 6144 + 3 * D;
        float acc[5] = {0.f, 0.f, 0.f, 0.f, 0.f};
        for (int k = F.wave * 128; k < F.wave * 128 + 128; ++k) { const float wv = *(const GAS float*)(w + (size_t)k * FF);
#pragma unroll
            for (int j = 0; j < 5; ++j) acc[j] += *(const GAS float*)(sh + (size_t)j * 6144 + k) * wv; }
#pragma unroll
        for (int j = 0; j < 5; ++j) red[(F.wave * 5 + j) * 64 + F.lane] = acc[j];
        __syncthreads();
        if (F.tid < 320) { const int j = F.tid / 64, n = F.tid % 64; float sum = F.in[22][l * FF + n0 + n];
            for (int w8 = 0; w8 < 8; ++w8) sum += red[(w8 * 5 + j) * 64 + n];
            ((float*)(F.ws + WS_SB1))[((size_t)l * 5 + j) * FF + n0 + n] = sum; }
        __syncthreads(); }
}
__device__ __forceinline__ void ph_ffn1(Frame& F, int l, int row_lo, int nrows) {
    pg8::TileOrder S; S.init(nrows / 256, FF / 256, F.G, F.bid, F.ws + WS_QO + (size_t)row_lo * D * 2, (size_t)256 * D * 2, F.ws + WS_W + W_1, (size_t)256 * D * 2);
    pg8::EpiFfn1 E{(bf16*)(F.ws + WS_FF), (const float*)(F.ws + WS_SB1) + (size_t)l * 5 * FF, (const float*)(F.ws + WS_CTL + CTL_SUMSQ2) + (size_t)l * M, row_lo};
    pg8::gemm_phase<pg8::EpiFfn1, pg8::TileOrder>(F.lds, pg8::Shape{D, D, D / 64}, S, E, F.tid);
}

#include <hip/hip_bf16.h>
#include <cmath>
namespace attn_body {
using bf16=__hip_bfloat16;
using bf16x8=__attribute__((ext_vector_type(8)))short;
using s16x4=__attribute__((ext_vector_type(4)))short;
using f32x16=__attribute__((ext_vector_type(16)))float;
using u32x4=__attribute__((ext_vector_type(4)))unsigned;
constexpr int D=64,DM=1024,KVP=128;
constexpr int NW=8,QBLK=32,QB=QBLK*NW,KVBLK=64;
constexpr int ATTN_PITCH=DM, ATTN_UNIT_ROWS=QB;
__device__ __forceinline__ int crow(int r,int hi){return (r&3)+8*(r>>2)+4*hi;}
#define SBAR() __builtin_amdgcn_sched_barrier(0)
__device__ __forceinline__ void cmask(f32x16&p0,f32x16&p1,int jb,int qrel,int hi){
  const float NEG=-INFINITY; int kb=64*jb+4*hi;
  #pragma unroll
  for(int r=0;r<16;++r){int kv=kb+(r&3)+8*(r>>2); if(kv>qrel)p0[r]=NEG; if(kv+32>qrel)p1[r]=NEG;}
}

constexpr int NSLOT=3, SLOTB=8192;
constexpr int LDS_K=0, LDS_V=NSLOT*SLOTB, LDS_WS=2*NSLOT*SLOTB, LDS_OST=LDS_WS+NW*64*4, LDS_BYTES=LDS_OST+NW*4096;
constexpr float C2=0.125f*1.4426950408889634f;
__device__ __forceinline__ void glds16(const void*gsrc,unsigned lds_dst){unsigned keep;
  asm volatile("s_mov_b32 %0, m0\n\ts_mov_b32 m0, %2\n\ts_nop 0\n\tglobal_load_lds_dwordx4 %1, off\n\ts_mov_b32 m0, %0":"=&s"(keep):"v"(gsrc),"s"(lds_dst):"memory");}
__device__ __forceinline__ float max3f(float a,float b,float c){float r;asm("v_max3_f32 %0, %1, %2, %3":"=v"(r):"v"(a),"v"(b),"v"(c));return r;}
__device__ __forceinline__ float max2f(float a,float b){float r;asm("v_max_f32_e32 %0, %1, %2":"=v"(r):"v"(a),"v"(b));return r;}
__device__ __forceinline__ float fadd_s(float a,float b){float r;asm("v_add_f32_e32 %0, %1, %2":"=v"(r):"v"(a),"v"(b));return r;}
__device__ __forceinline__ float fsub_s(float a,float b){float r;asm("v_sub_f32_e32 %0, %1, %2":"=v"(r):"v"(a),"v"(b));return r;}
typedef float f32x2_t __attribute__((ext_vector_type(2))); typedef __bf16 bf16x2_t __attribute__((ext_vector_type(2)));
__device__ __forceinline__ unsigned cvtpk_s(float lo,float hi){f32x2_t v={lo,hi};bf16x2_t b=__builtin_convertvector(v,bf16x2_t);return __builtin_bit_cast(unsigned,b);}
#define WAIT_BAR(N) asm volatile("s_waitcnt vmcnt(" #N ") lgkmcnt(0)\n\ts_barrier":::"memory")

__device__ __forceinline__ void qkt(f32x16&p0,f32x16&p1,const char*Kslot,const bf16x8*qr,const f32x16&negm,int r32,int hi){
  const char*kb=Kslot+hi*1024+r32*16;
  #pragma unroll
  for(int d0=0;d0<4;++d0){
    const bf16x8 b0=*reinterpret_cast<const bf16x8*>(kb+d0*2048);
    const bf16x8 b1=*reinterpret_cast<const bf16x8*>(kb+d0*2048+512);
    if(d0==0){p0=__builtin_amdgcn_mfma_f32_32x32x16_bf16(b0,qr[0],negm,0,0,0);p1=__builtin_amdgcn_mfma_f32_32x32x16_bf16(b1,qr[0],negm,0,0,0);}
    else{p0=__builtin_amdgcn_mfma_f32_32x32x16_bf16(b0,qr[d0],p0,0,0,0);p1=__builtin_amdgcn_mfma_f32_32x32x16_bf16(b1,qr[d0],p1,0,0,0);}}
}
typedef __attribute__((address_space(3))) const char* lds_cptr;
typedef short v4i16_t __attribute__((ext_vector_type(4)));
__device__ __forceinline__ void kload8(bf16x8*kf,lds_cptr kp){
  kf[0]=*(const __attribute__((address_space(3))) bf16x8*)(kp);      kf[1]=*(const __attribute__((address_space(3))) bf16x8*)(kp+512);
  kf[2]=*(const __attribute__((address_space(3))) bf16x8*)(kp+2048); kf[3]=*(const __attribute__((address_space(3))) bf16x8*)(kp+2560);
  kf[4]=*(const __attribute__((address_space(3))) bf16x8*)(kp+4096); kf[5]=*(const __attribute__((address_space(3))) bf16x8*)(kp+4608);
  kf[6]=*(const __attribute__((address_space(3))) bf16x8*)(kp+6144); kf[7]=*(const __attribute__((address_space(3))) bf16x8*)(kp+6656);
}
__device__ __forceinline__ void kload2(bf16x8*kf,lds_cptr kp,int j){ kf[2*j]=*(const __attribute__((address_space(3))) bf16x8*)(kp+j*2048); kf[2*j+1]=*(const __attribute__((address_space(3))) bf16x8*)(kp+j*2048+512); }
__device__ __forceinline__ s16x4 vtr(lds_cptr p){ return __builtin_bit_cast(s16x4,__builtin_amdgcn_ds_read_tr16_b64_v4i16((__attribute__((address_space(3))) v4i16_t*)p)); }
__device__ __forceinline__ float rowmax(const f32x16&p0,const f32x16&p1){
  float a=max3f(p0[0],p0[1],p1[0]),b=max3f(p0[2],p0[3],p1[1]);a=max3f(a,p1[2],p1[3]);
  #pragma unroll
  for(int r=4;r<16;r+=4){a=max3f(a,p0[r],p0[r+1]);b=max3f(b,p0[r+2],p0[r+3]);a=max3f(a,p1[r],p1[r+1]);b=max3f(b,p1[r+2],p1[r+3]);}
  const float m=max2f(a,b);
  auto rr=__builtin_amdgcn_permlane32_swap(__float_as_uint(m),__float_as_uint(m),false,false);
  return max2f(__uint_as_float(rr[0]),__uint_as_float(rr[1]));
}
__device__ __forceinline__ void pv(f32x16*o,int vb,bf16x8 pa0,bf16x8 pa1,bf16x8 pa2,bf16x8 pa3){
  #pragma unroll
  for(int d0=0;d0<2;++d0){s16x4 lo[4],hi[4];
    #pragma unroll
    for(int ks=0;ks<4;++ks){
      asm volatile("ds_read_b64_tr_b16 %0,%1 offset:%c2":"=&v"(lo[ks]):"v"(vb),"i"(d0*4096+ks*1024):"memory");
      asm volatile("ds_read_b64_tr_b16 %0,%1 offset:%c2":"=&v"(hi[ks]):"v"(vb),"i"(d0*4096+ks*1024+512):"memory");}
    asm volatile("s_waitcnt lgkmcnt(0)":::"memory");SBAR();
    #define PK(k) (bf16x8){lo[k][0],lo[k][1],lo[k][2],lo[k][3],hi[k][0],hi[k][1],hi[k][2],hi[k][3]}
    o[d0]=__builtin_amdgcn_mfma_f32_32x32x16_bf16(pa0,PK(0),o[d0],0,0,0);
    o[d0]=__builtin_amdgcn_mfma_f32_32x32x16_bf16(pa1,PK(1),o[d0],0,0,0);
    o[d0]=__builtin_amdgcn_mfma_f32_32x32x16_bf16(pa2,PK(2),o[d0],0,0,0);
    o[d0]=__builtin_amdgcn_mfma_f32_32x32x16_bf16(pa3,PK(3),o[d0],0,0,0);
    #undef PK
  }
}

#ifndef ATTN_STORE16
#define ATTN_STORE16(p,v) (*(__attribute__((address_space(1))) u32x4*)(p)=(v))
#endif
template<int THRL> __device__ __forceinline__ void attn_unit(bf16*Qu,const bf16*__restrict__ Kh,const bf16*__restrict__ Vh,const int NT,char*shm,const int tid_in){
  int tid=tid_in; asm volatile("":"+v"(tid));
  const int lane=tid&63,r32=lane&31,hi=lane>>5; const int wid=__builtin_amdgcn_readfirstlane(tid>>6);
  const bf16*Qw=Qu+(long)(wid*QBLK)*DM;
  const unsigned lds0=(unsigned)(uintptr_t)shm;
  float*wsf=(float*)(shm+LDS_WS)+wid*64;
  const bf16*ksrc=Kh+(long)lane*KVP+wid*8;
  const bf16*vsrc=Vh+(long)(16*(wid&3)+(lane>>2))*KVP+(wid>>2)*32+(lane&3)*8;
  const unsigned kdst=lds0+LDS_K+wid*1024, vdst=lds0+LDS_V+wid*1024;
  #define DMA_K(t,slot) glds16(ksrc+(long)(t)*KVBLK*KVP,(unsigned)__builtin_amdgcn_readfirstlane(kdst+(slot)))
  #define DMA_V(t,slot) glds16(vsrc+(long)(t)*KVBLK*KVP,(unsigned)__builtin_amdgcn_readfirstlane(vdst+(slot)))
  const int vb0=(int)(lds0+LDS_V)+((lane>>4)&1)*32+(lane&3)*8+(4*hi+((lane&15)>>2))*64;
  const char*Kbase=shm+LDS_K; bf16x8 kf[8];
  const lds_cptr shm3=(lds_cptr)shm; const lds_cptr kp0=shm3+LDS_K+hi*1024+r32*16; const lds_cptr vp0=shm3+LDS_V+((lane>>4)&1)*32+(lane&3)*8+(4*hi+((lane&15)>>2))*64;
  DMA_K(0,0);DMA_V(0,0);DMA_K(1,SLOTB);
  bf16x8 qr[4];
  #pragma unroll
  for(int d0=0;d0<4;++d0)qr[d0]=*(const __attribute__((address_space(1))) bf16x8*)(&Qw[(long)r32*DM+d0*16+hi*8]);
  float mhat=0.f,l_reg=0.f;f32x16 o[2];o[0]=f32x16{};o[1]=f32x16{};f32x16 negm=f32x16{};asm volatile("":"+v"(negm));
  #define CMASK(P0,P1,t) do{}while(0)
  bool resc=false;
  #define START(P0,P1) do{ const float rm=rowmax(P0,P1); resc=false; \
    { const float dl=rm; mhat=fadd_s(mhat,dl); \
      _Pragma("unroll") for(int r=0;r<16;++r){P0[r]=fsub_s(P0[r],dl);P1[r]=fsub_s(P1[r],dl);} \
      _Pragma("unroll") for(int r=0;r<16;++r)negm[r]=-mhat; asm volatile("":"+v"(negm)); } \
    _Pragma("unroll") for(int r=0;r<16;++r)P0[r]=__builtin_amdgcn_exp2f(P0[r]); }while(0)
  #define RESC() do{ if(resc){ asm volatile("s_waitcnt lgkmcnt(0)":::"memory"); \
      _Pragma("unroll") for(int d_=0;d_<2;++d_) _Pragma("unroll") for(int r=0;r<16;++r)o[d_][r]*=wsf[crow(r,hi)]; } }while(0)
  f32x16 pA0,pA1,pB0,pB1;
  int sl_prev=0,sl_cur=0,sl_next=SLOTB;
  #define ROT() do{sl_prev=sl_cur;sl_cur=sl_next;sl_next=(sl_next==(NSLOT-1)*SLOTB)?0:sl_next+SLOTB;}while(0)
  DMA_K(2,2*SLOTB);
  WAIT_BAR(3);
  qkt(pA0,pA1,Kbase,qr,negm,r32,hi);asm volatile("s_nop 15\n\ts_nop 7":"+v"(pA0),"+v"(pA1));CMASK(pA0,pA1,0);
  START(pA0,pA1);
  _Pragma("unroll") for(int r=0;r<16;++r)pA1[r]=__builtin_amdgcn_exp2f(pA1[r]);
  WAIT_BAR(0);
  DMA_K(3,0);DMA_V(1,SLOTB);
  ROT();
  kload8(kf,kp0+sl_cur);
  WAIT_BAR(2);
  s16x4 vlo[8],vhi[8]; u32x4 pw0,pw1,pw2,pw3;
  #define PKW(P,B) cvtpk_s(P[B],P[B+1])
  #define PAF(k) __builtin_bit_cast(bf16x8,pw##k)
  #define VFR(i) (bf16x8){vlo[i][0],vlo[i][1],vlo[i][2],vlo[i][3],vhi[i][0],vhi[i][1],vhi[i][2],vhi[i][3]}
  #define PIN(x) asm volatile("":"+v"(x))
  #define MX3(a,b,c) __builtin_fmaxf(__builtin_fmaxf((a),(b)),(c))
  #define GAPA(MF,A0,A1,A2,A3,W0,W1,PW) do{ MF; sacc+=A0; sacc+=A1; sacc+=A2; sacc+=A3; PIN(sacc); W0; W1; PIN(PW); SBAR(); }while(0)
  #define EX(v) __builtin_amdgcn_exp2f(v)
  #define GAPB(MF,X,B) do{ MF; X[B]=EX(X[B]); X[B+1]=EX(X[B+1]); X[B+2]=EX(X[B+2]); X[B+3]=EX(X[B+3]); PIN(X); SBAR(); }while(0)
  #define VRD(i) do{ vlo[i]=vtr(vp_+(((i)>>2)*4096+((i)&3)*1024)); vhi[i]=vtr(vp_+(((i)>>2)*4096+((i)&3)*1024+512)); }while(0)
  #define KRD(G,j) do{ if(G){ kload2(kf,kp0+sl_next,j); SBAR(); } }while(0)
  #define STEP(C0,C1,P0,P1,t,GK,GV,GL) do{ SBAR(); \
    const lds_cptr vp_=vp0+sl_prev; \
    VRD(0); SBAR(); float sacc=(P0[0]+P0[1]); \
    GAPA(C0=__builtin_amdgcn_mfma_f32_32x32x16_bf16(kf[0],qr[0],negm,0,0,0), P0[2],P0[3],P0[4],P0[5],     pw0[0]=PKW(P0,0), pw0[1]=PKW(P0,2), pw0); \
    VRD(4); SBAR(); GAPA(C1=__builtin_amdgcn_mfma_f32_32x32x16_bf16(kf[1],qr[0],negm,0,0,0), P0[6],P0[7],P0[8],P0[9],     pw0[2]=PKW(P0,4), pw0[3]=PKW(P0,6), pw0); \
    VRD(1); SBAR(); GAPA(C0=__builtin_amdgcn_mfma_f32_32x32x16_bf16(kf[2],qr[1],C0,0,0,0),   P0[10],P0[11],P0[12],P0[13], pw1[0]=PKW(P0,8), pw1[1]=PKW(P0,10), pw1); \
    VRD(5); SBAR(); GAPA(C1=__builtin_amdgcn_mfma_f32_32x32x16_bf16(kf[3],qr[1],C1,0,0,0),   P0[14],P0[15],P1[0],P1[1],   pw1[2]=PKW(P0,12),pw1[3]=PKW(P0,14), pw1); \
    VRD(2); SBAR(); GAPA(C0=__builtin_amdgcn_mfma_f32_32x32x16_bf16(kf[4],qr[2],C0,0,0,0),   P1[2],P1[3],P1[4],P1[5],     pw2[0]=PKW(P1,0), pw2[1]=PKW(P1,2), pw2); \
    VRD(6); SBAR(); GAPA(C1=__builtin_amdgcn_mfma_f32_32x32x16_bf16(kf[5],qr[2],C1,0,0,0),   P1[6],P1[7],P1[8],P1[9],     pw2[2]=PKW(P1,4), pw2[3]=PKW(P1,6), pw2); \
    VRD(3); SBAR(); GAPA(C0=__builtin_amdgcn_mfma_f32_32x32x16_bf16(kf[6],qr[3],C0,0,0,0),   P1[10],P1[11],P1[12],P1[13], pw3[0]=PKW(P1,8), pw3[1]=PKW(P1,10), pw3); \
    VRD(7); SBAR(); GAPA(C1=__builtin_amdgcn_mfma_f32_32x32x16_bf16(kf[7],qr[3],C1,0,0,0),   P1[14],P1[15],0.f,0.f,       pw3[2]=PKW(P1,12),pw3[3]=PKW(P1,14), pw3); \
    l_reg+=sacc; \
    if(GK){DMA_K((t)+3,sl_cur);} if(GV){DMA_V((t)+1,sl_next);} \
    CMASK(C0,C1,t); \
    { float a=MX3(C0[0],C0[1],C1[0]),b=MX3(C0[2],C0[3],C1[1]); a=MX3(a,C1[2],C1[3]); \
      _Pragma("unroll") for(int r=4;r<16;r+=4){a=MX3(a,C0[r],C0[r+1]);b=MX3(b,C0[r+2],C0[r+3]);a=MX3(a,C1[r],C1[r+1]);b=MX3(b,C1[r+2],C1[r+3]);} \
      float rm=__builtin_fmaxf(a,b); { auto rr=__builtin_amdgcn_permlane32_swap(__float_as_uint(rm),__float_as_uint(rm),false,false); rm=__builtin_fmaxf(__uint_as_float(rr[0]),__uint_as_float(rr[1])); } \
      resc=false; \
      if(__builtin_expect(__any(rm>(float)THRL),0)){ const float dl=__builtin_fmaxf(rm,0.f); mhat+=dl; \
        _Pragma("unroll") for(int r=0;r<16;++r){C0[r]-=dl;C1[r]-=dl;} \
        _Pragma("unroll") for(int r=0;r<16;++r)negm[r]=-mhat; asm volatile("":"+v"(negm)); \
        const float f=__builtin_amdgcn_exp2f(-dl); l_reg*=f; if(hi==0)wsf[r32]=f; resc=true; } } \
    SBAR(); \
    GAPB(o[0]=__builtin_amdgcn_mfma_f32_32x32x16_bf16(PAF(0),VFR(0),o[0],0,0,0), C0,0); \
    GAPB(o[1]=__builtin_amdgcn_mfma_f32_32x32x16_bf16(PAF(0),VFR(4),o[1],0,0,0), C0,4); \
    KRD(GL,0); GAPB(o[0]=__builtin_amdgcn_mfma_f32_32x32x16_bf16(PAF(1),VFR(1),o[0],0,0,0), C0,8); \
    KRD(GL,1); GAPB(o[1]=__builtin_amdgcn_mfma_f32_32x32x16_bf16(PAF(1),VFR(5),o[1],0,0,0), C0,12); \
    KRD(GL,2); GAPB(o[0]=__builtin_amdgcn_mfma_f32_32x32x16_bf16(PAF(2),VFR(2),o[0],0,0,0), C1,0); \
    KRD(GL,3); GAPB(o[1]=__builtin_amdgcn_mfma_f32_32x32x16_bf16(PAF(2),VFR(6),o[1],0,0,0), C1,4); \
    GAPB(o[0]=__builtin_amdgcn_mfma_f32_32x32x16_bf16(PAF(3),VFR(3),o[0],0,0,0), C1,8); \
    GAPB(o[1]=__builtin_amdgcn_mfma_f32_32x32x16_bf16(PAF(3),VFR(7),o[1],0,0,0), C1,12); \
    }while(0)
  int t=1;
  #undef CMASK
  #define CMASK(P0,P1,t) do{}while(0)
  for(;t+5<NT;t+=2){
    STEP(pB0,pB1,pA0,pA1,t,true,true,true);     WAIT_BAR(2); RESC(); ROT();
    STEP(pA0,pA1,pB0,pB1,t+1,true,true,true);   WAIT_BAR(2); RESC(); ROT();
  }
  #undef CMASK
  #define CMASK(P0,P1,t) do{}while(0)
  #define ENDW(tt) do{ if((tt)+3<NT){WAIT_BAR(2);} else if((tt)+2<NT){WAIT_BAR(1);} else {WAIT_BAR(0);} }while(0)
  for(;t+1<NT;t+=2){
    STEP(pB0,pB1,pA0,pA1,t,(t+3<NT),(t+1<NT),(t+1<NT));       ENDW(t);   RESC(); ROT();
    STEP(pA0,pA1,pB0,pB1,t+1,(t+4<NT),(t+2<NT),(t+2<NT));     ENDW(t+1); RESC(); ROT();
  }
  STEP(pB0,pB1,pA0,pA1,NT-1,false,false,false); RESC();
  { float sacc=pB0[0]+pB0[1]; _Pragma("unroll") for(int r=2;r<16;++r)sacc+=pB0[r]; _Pragma("unroll") for(int r=0;r<16;++r)sacc+=pB1[r]; l_reg+=sacc;
    pw0=(u32x4){PKW(pB0,0),PKW(pB0,2),PKW(pB0,4),PKW(pB0,6)};pw1=(u32x4){PKW(pB0,8),PKW(pB0,10),PKW(pB0,12),PKW(pB0,14)};pw2=(u32x4){PKW(pB1,0),PKW(pB1,2),PKW(pB1,4),PKW(pB1,6)};pw3=(u32x4){PKW(pB1,8),PKW(pB1,10),PKW(pB1,12),PKW(pB1,14)};
    SBAR(); pv(o,vb0+sl_cur,PAF(0),PAF(1),PAF(2),PAF(3)); }
  #undef PKW
  #undef PAF
  #undef VFR
  #undef PIN
  #undef MX3
  #undef GAPA
  #undef GAPB
  #undef EX
  #undef VRD
  #undef KRD
  #undef STEP
  #undef ENDW
  {auto rr=__builtin_amdgcn_permlane32_swap(__float_as_uint(l_reg),__float_as_uint(l_reg),false,false);l_reg=__uint_as_float(rr[0])+__uint_as_float(rr[1]);}
  if(hi==0)wsf[32+r32]=l_reg;asm volatile("s_waitcnt lgkmcnt(0)":::"memory");
  float rli[16];
  #pragma unroll
  for(int r=0;r<16;++r)rli[r]=__builtin_amdgcn_rcpf(wsf[32+crow(r,hi)]);
  bf16*Ow=Qu+(long)(wid*QBLK)*DM;
  { bf16*stg=(bf16*)(shm+LDS_OST)+wid*2048;
    #pragma unroll
    for(int r=0;r<16;++r){const int orow=crow(r,hi);
      #pragma unroll
      for(int d0=0;d0<2;++d0)stg[orow*64+d0*32+r32]=__float2bfloat16(o[d0][r]*rli[r]);}
    asm volatile("s_waitcnt lgkmcnt(0)":::"memory");
    #pragma unroll
    for(int i=0;i<4;++i){const int row=i*8+(lane>>3),ch=lane&7; const u32x4 v=*(const u32x4*)(stg+row*64+ch*8); ATTN_STORE16(Ow+(long)row*DM+ch*8,v);} }
  asm volatile("s_waitcnt lgkmcnt(0)\n\ts_barrier":::"memory");
  #undef DMA_K
  #undef DMA_V
  #undef CMASK
  #undef START
  #undef RESC
  #undef ROT
}
constexpr int ATTN_LDS_BYTES=LDS_BYTES;
#undef SBAR
#undef WAIT_BAR
}

__device__ __forceinline__ void attn_units(Frame& F, char* lds_generic) {
    typedef attn_body::bf16 abf;
    const bool bal = F.G == 256; const int jj = (F.bid >> 3) - 8, x = F.bid & 7;
    if (F.bid >= 64) {
        const int W = F.G - 64, j = F.bid - 64; const bool xaff = (F.G & 7) == 0; const int nper = W >> 3;
        for (int i = 0;; ++i) {
            int b, h, qb;
            if (xaff) { const int r = jj + i * nper; if (r >= 64) break; b = x >> 1; h = 4 * (x & 1) + (r & 3); qb = r >> 2; }
            else { const int idx = j + i * W; if (idx >= 512) break; const int xx = idx & 7, r = idx >> 3; b = xx >> 1; h = 4 * (xx & 1) + (r & 3); qb = r >> 2; }
            const int kvh = h >> 2;
            abf* Qu = (abf*)(F.ws + WS_QO) + (size_t)(MP + b * TS + qb * 256) * D + h * 64;
            const abf* Kh = (const abf*)(F.ws + WS_KS) + (size_t)b * KEYS_S * 128 + kvh * 64; const abf* Vh = (const abf*)(F.ws + WS_VS) + (size_t)b * KEYS_S * 128 + kvh * 64;
            attn_body::attn_unit<8>(Qu, Kh, Vh, KEYS_S / 64, lds_generic, F.tid);
        }
    }
    int i0, istep, icnt;
    if (bal) { if (F.bid < 64) { i0 = 2 * F.bid; istep = 1; icnt = 2; } else if (jj >= 16) { i0 = 128 + 2 * (x * 8 + (jj - 16)); istep = 1; icnt = 2; } else { i0 = 0; istep = 1; icnt = 0; } }
    else { if (F.bid < 64) { i0 = 0; istep = 1; icnt = 0; } else { i0 = F.bid - 64; istep = F.G - 64; icnt = (NPB * NQH - i0 + istep - 1) / istep; } }
    for (int k = 0; k < icnt; ++k) { const int idx = i0 + k * istep; if (idx >= NPB * NQH) break;
        const int b = idx >> 3, h = idx & 7, kvh = h >> 2;
        abf* Qu = (abf*)(F.ws + WS_QO) + (size_t)(b * TP) * D + h * 64;
        const abf* Kh = (const abf*)(F.ws + WS_KP) + (size_t)b * TP * 128 + kvh * 64; const abf* Vh = (const abf*)(F.ws + WS_VP) + (size_t)b * TP * 128 + kvh * 64;
        attn_body::attn_unit<8>(Qu, Kh, Vh, TP / 64, lds_generic, F.tid);
    }
}

__device__ __forceinline__ void ph_delta_pre(Frame& F, int l) {
    bf16* CONV = (bf16*)(F.ws + WS_CONV); const bf16* BND = (const bf16*)(F.ws + WS_BND); float* LA = (float*)(F.ws + WS_LA); const float* BETA = (const float*)(F.ws + WS_BETA); bf16* TP = (bf16*)(F.ws + WS_H);
    const float* cw = F.in[12] + (size_t)l * 3 * CONVC;
    LAS unsigned char* Kl = F.lds;
    LAS float* KK = (LAS float*)(F.lds + 36864);
    LAS float* GB = (LAS float*)(F.lds + 36864 + 69632) + F.wave * 128;
    const int r = F.tid >> 3, cb = (F.tid & 7) * 8, lane = F.lane, q4 = lane >> 4, l15 = lane & 15;
    const int hh = F.wave >> 1, dirw = F.wave & 1;
    for (int it = F.bid; it < (M / 64) * 2; it += F.G) {
        const int ck = it >> 1, hq = it & 1; const int cs = ck < MP / 64 ? (ck & 3) : ((ck - MP / 64) & 63), ncs = ck < MP / 64 ? 4 : 64;
        const size_t tok = (size_t)ck * 64 + r;
        for (int h4 = 0; h4 < 4; ++h4) { const int h = 4 * hq + h4;
            float y[3][8];
#pragma unroll
            for (int s3 = 0; s3 < 3; ++s3) { const int col = s3 * 512 + h * 64 + cb;
                const v4u x0 = *(const GAS v4u*)(CONV + tok * CONVC + col);
                v4u xm = (v4u){0u, 0u, 0u, 0u}, xp = (v4u){0u, 0u, 0u, 0u};
                if (r > 0) xm = *(const GAS v4u*)(CONV + (tok - 1) * CONVC + col); else if (cs > 0) xm = *(const GAS v4u*)(BND + ((size_t)(ck - 1) * 2 + 1) * CONVC + col);
                if (r < 63) xp = *(const GAS v4u*)(CONV + (tok + 1) * CONVC + col); else if (cs < ncs - 1) xp = *(const GAS v4u*)(BND + ((size_t)(ck + 1) * 2) * CONVC + col);
                const f32x4 w0a = *(const GAS f32x4*)(cw + col), w0b = *(const GAS f32x4*)(cw + col + 4), w1a = *(const GAS f32x4*)(cw + CONVC + col), w1b = *(const GAS f32x4*)(cw + CONVC + col + 4),
                            w2a = *(const GAS f32x4*)(cw + 2 * CONVC + col), w2b = *(const GAS f32x4*)(cw + 2 * CONVC + col + 4);
                const float w0[8] = {w0a[0], w0a[1], w0a[2], w0a[3], w0b[0], w0b[1], w0b[2], w0b[3]}, w1[8] = {w1a[0], w1a[1], w1a[2], w1a[3], w1b[0], w1b[1], w1b[2], w1b[3]}, w2[8] = {w2a[0], w2a[1], w2a[2], w2a[3], w2b[0], w2b[1], w2b[2], w2b[3]};
                const unsigned xmw[4] = {xm.x, xm.y, xm.z, xm.w}, x0w[4] = {x0.x, x0.y, x0.z, x0.w}, xpw[4] = {xp.x, xp.y, xp.z, xp.w};
#pragma unroll
                for (int i = 0; i < 8; ++i) { const float a = (i & 1) ? bfhi(xmw[i >> 1]) : bflo(xmw[i >> 1]), b = (i & 1) ? bfhi(x0w[i >> 1]) : bflo(x0w[i >> 1]), c = (i & 1) ? bfhi(xpw[i >> 1]) : bflo(xpw[i >> 1]);
                    y[s3][i] = siluf_(a * w0[i] + b * w1[i] + c * w2[i]); }
                if (s3 < 2) { float ss = 0.f;
#pragma unroll
                    for (int i = 0; i < 8; ++i) ss += y[s3][i] * y[s3][i];
                    ss += shx(ss, 1, lane); ss += shx(ss, 2, lane); ss += shx(ss, 4, lane);
                    const float sc = (s3 == 0 ? 0.125f : 1.f) / sqrtf(ss + EPS);
#pragma unroll
                    for (int i = 0; i < 8; ++i) y[s3][i] *= sc; }
            }
            __syncthreads();
            v4u pk[3];
#pragma unroll
            for (int s3 = 0; s3 < 3; ++s3) { pk[s3] = (v4u){pk2(y[s3][0], y[s3][1]), pk2(y[s3][2], y[s3][3]), pk2(y[s3][4], y[s3][5]), pk2(y[s3][6], y[s3][7])};
                *(GAS v4u*)(CONV + tok * CONVC + s3 * 512 + h * 64 + cb) = pk[s3]; }
            *(LAS v4u*)(Kl + h4 * 9216 + r * 144 + cb * 2) = pk[1];
        }
        __syncthreads();
        { const LAS unsigned char* Kh = Kl + hh * 9216;
#pragma unroll
          for (int mi = 0; mi < 2; ++mi) { const int mt = 2 * dirw + mi;
              const pg8::bf16x8 a0 = *(const LAS pg8::bf16x8*)(Kh + (16 * mt + l15) * 144 + (8 * q4) * 2), a1 = *(const LAS pg8::bf16x8*)(Kh + (16 * mt + l15) * 144 + (32 + 8 * q4) * 2);
#pragma unroll
              for (int nt = 0; nt < 4; ++nt) { const pg8::bf16x8 b0 = *(const LAS pg8::bf16x8*)(Kh + (16 * nt + l15) * 144 + (8 * q4) * 2), b1 = *(const LAS pg8::bf16x8*)(Kh + (16 * nt + l15) * 144 + (32 + 8 * q4) * 2);
                  f32x4 c = (f32x4){0.f, 0.f, 0.f, 0.f};
                  c = __builtin_amdgcn_mfma_f32_16x16x32_bf16(a0, b0, c, 0, 0, 0); c = __builtin_amdgcn_mfma_f32_16x16x32_bf16(a1, b1, c, 0, 0, 0);
#pragma unroll
                  for (int rg = 0; rg < 4; ++rg) KK[hh * 4352 + (16 * mt + 4 * q4 + rg) * 68 + 16 * nt + l15] = c[rg]; } } }
        __syncthreads();
        { const int h = 4 * hq + hh; const size_t ga = ((size_t)ck * 64 + (dirw ? 63 - lane : lane)) * 16 + dirw * 8 + h;
          float g = LA[ga]; const float bt = BETA[ga];
#pragma unroll
          for (int o = 1; o < 64; o <<= 1) { const float t = shl_from(g, lane - o); if (lane >= o) g += t; }
          LA[ga] = g; GB[lane] = g; GB[64 + lane] = bt;
          LAS float* Lm = KK + hh * 4352;
          for (int i = 1; i < 64; ++i) { const float bi = GB[64 + i], gi = GB[i];
              if (lane < i) { const int ad = dirw ? (63 - i) * 68 + (63 - lane) : i * 68 + lane; Lm[ad] = bi * Lm[ad] * __expf(gi - g); } }
          LAS float* Sd = (LAS float*)(Kl + F.wave * 4608);
#define LROW4(row, c4) ({ f32x4 v_; if (dirw) { const f32x4 t_ = *(const LAS f32x4*)(Lm + (63 - (row)) * 68 + (60 - (c4))); v_ = (f32x4){t_[3], t_[2], t_[1], t_[0]}; } else v_ = *(const LAS f32x4*)(Lm + (row) * 68 + (c4)); v_; })
          float x[16];
#pragma unroll
          for (int i = 0; i < 16; ++i) { float acc = (i == l15) ? 1.f : 0.f;
#pragma unroll
              for (int m4 = 0; m4 < (i + 3) / 4; ++m4) { const f32x4 v = LROW4(16 * q4 + i, 16 * q4 + 4 * m4);
#pragma unroll
                  for (int t = 0; t < 4; ++t) { if (4 * m4 + t < i) acc -= v[t] * x[4 * m4 + t]; } }
              x[i] = acc; Sd[q4 * 256 + i * 16 + l15] = acc; }
          bf16* tile = TP + (((size_t)ck * 2 + dirw) * NDH + h) * 4096;
          { bf16* dst = tile + (size_t)lane * 64 + 16 * q4;
            *(GAS v4u*)dst = (v4u){pk2(x[0] * bt, x[1] * bt), pk2(x[2] * bt, x[3] * bt), pk2(x[4] * bt, x[5] * bt), pk2(x[6] * bt, x[7] * bt)};
            *(GAS v4u*)(dst + 8) = (v4u){pk2(x[8] * bt, x[9] * bt), pk2(x[10] * bt, x[11] * bt), pk2(x[12] * bt, x[13] * bt), pk2(x[14] * bt, x[15] * bt)}; }
          f32x4 To[4][4];
#define MM_L_SCR(C, aa, cc) do { const f32x4 av_ = LROW4(16 * (aa) + l15, 16 * (cc) + 4 * q4); _Pragma("unroll") for (int r_ = 0; r_ < 4; ++r_) \
              C = __builtin_amdgcn_mfma_f32_16x16x4f32(av_[r_], Sd[(cc) * 256 + (4 * q4 + r_) * 16 + l15], C, 0, 0, 0); } while (0)
#define MM_L_REG(C, aa, cc, B) do { const f32x4 av_ = LROW4(16 * (aa) + l15, 16 * (cc) + 4 * q4); _Pragma("unroll") for (int r_ = 0; r_ < 4; ++r_) \
              C = __builtin_amdgcn_mfma_f32_16x16x4f32(av_[r_], (B)[r_], C, 0, 0, 0); } while (0)
#define MM_T_REG(C, aa, B) do { const f32x4 av_ = *(const LAS f32x4*)(Sd + (aa) * 256 + l15 * 16 + 4 * q4); _Pragma("unroll") for (int r_ = 0; r_ < 4; ++r_) \
              C = __builtin_amdgcn_mfma_f32_16x16x4f32(av_[r_], (B)[r_], C, 0, 0, 0); } while (0)
#pragma unroll
          for (int bb = 0; bb < 3; ++bb) { f32x4 Mx = (f32x4){0.f, 0.f, 0.f, 0.f}, c = Mx; MM_L_SCR(Mx, bb + 1, bb); MM_T_REG(c, bb + 1, Mx); To[bb + 1][bb] = -c; }
#pragma unroll
          for (int bb = 0; bb < 2; ++bb) { f32x4 Mx = (f32x4){0.f, 0.f, 0.f, 0.f}, c = Mx; MM_L_SCR(Mx, bb + 2, bb); MM_L_REG(Mx, bb + 2, bb + 1, To[bb + 1][bb]); MM_T_REG(c, bb + 2, Mx); To[bb + 2][bb] = -c; }
          { f32x4 Mx = (f32x4){0.f, 0.f, 0.f, 0.f}, c = Mx; MM_L_SCR(Mx, 3, 0); MM_L_REG(Mx, 3, 1, To[1][0]); MM_L_REG(Mx, 3, 2, To[2][0]); MM_T_REG(c, 3, Mx); To[3][0] = -c; }
#undef MM_L_SCR
#undef MM_L_REG
#undef MM_T_REG
#undef LROW4
#pragma unroll
          for (int bb = 0; bb < 4; ++bb) { const float bj = GB[64 + 16 * bb + l15]; bf16* rowp = tile + (size_t)(16 * bb + l15) * 64 + 4 * q4;
#pragma unroll
              for (int aa = 0; aa < 4; ++aa) { if (aa == bb) continue;
                  const f32x4 t = aa > bb ? To[aa][bb] * bj : (f32x4){0.f, 0.f, 0.f, 0.f};
                  *(GAS v2u*)(rowp + 16 * aa) = (v2u){pk2(t[0], t[1]), pk2(t[2], t[3])}; } }
        }
        __syncthreads();
    }
}
__device__ __forceinline__ v4u gld16_asm(const void* p) { v4u r; asm volatile("global_load_dwordx4 %0, %1, off" : "=v"(r) : "v"(p) : "memory"); return r; }
__device__ __forceinline__ float gld4_asm(const void* p) { float r; asm volatile("global_load_dword %0, %1, off" : "=v"(r) : "v"(p) : "memory"); return r; }
__device__ __forceinline__ void ph_delta_scan(Frame& F, int l) {
    typedef pg8::bf16x8 bx8; typedef short s16x4 __attribute__((ext_vector_type(4))); typedef short v4i16_t __attribute__((ext_vector_type(4)));
    const bf16* CONV = (const bf16*)(F.ws + WS_CONV); const float* LA = (const float*)(F.ws + WS_LA); const bf16* TPB = (const bf16*)(F.ws + WS_H);
    const bf16* GOUT = (const bf16*)(F.ws + WS_GOUT); bf16* QO = (bf16*)(F.ws + WS_QO);
    float* nst = F.out + (size_t)M * D + 2 * (size_t)NPB * DEPTH * NKVH * TP * HD;
    const int lane = F.lane, slot = F.wave >> 2, gw = F.wave & 3, tg = F.tid & 255, q4 = lane >> 4, l15 = lane & 15;
    LAS unsigned char* LB = F.lds + slot * 65536;
    LAS unsigned char* KL = LB; LAS unsigned char* QL = LB + 9216; LAS unsigned char* TL = LB + 18432; LAS unsigned char* PL = LB + 27648; LAS unsigned char* VL = LB + 36864;
    LAS float* OL = (LAS float*)(LB + 46080);
    LAS float* GL = (LAS float*)(LB + 63488);
    const int orow_i = tg >> 2, ocq = (tg & 3) * 16;
#define LBAR() do { asm volatile("s_waitcnt lgkmcnt(0)" ::: "memory"); __builtin_amdgcn_s_barrier(); asm volatile("" ::: "memory"); } while (0)
#define TRD(p) __builtin_bit_cast(s16x4, __builtin_amdgcn_ds_read_tr16_b64_v4i16((LAS v4i16_t*)(p)))
#define A_ROW(IMG, row, s) ({ const v2u lo_ = *(const LAS v2u*)((IMG) + (row) * 144 + (32 * (s) + 4 * q4) * 2), hi_ = *(const LAS v2u*)((IMG) + (row) * 144 + (32 * (s) + 16 + 4 * q4) * 2); __builtin_bit_cast(bx8, (v4u){lo_.x, lo_.y, hi_.x, hi_.y}); })
#define A_TRN(IMG, mt, s) ({ const s16x4 lo_ = TRD((IMG) + (32 * (s) + 4 * q4 + (l15 >> 2)) * 144 + (16 * (mt) + 4 * (l15 & 3)) * 2), hi_ = TRD((IMG) + (32 * (s) + 16 + 4 * q4 + (l15 >> 2)) * 144 + (16 * (mt) + 4 * (l15 & 3)) * 2); (bx8){lo_[0], lo_[1], lo_[2], lo_[3], hi_[0], hi_[1], hi_[2], hi_[3]}; })
#define PACKB(X, s) __builtin_bit_cast(bx8, pg8::pack8((X)[2 * (s)], (X)[2 * (s) + 1]))
    for (int ii = 0;; ++ii) {
        int p;
        if (F.G == 256) {
            const int jj = (F.bid >> 3) - 8;
            if (F.bid < 64) { if (ii > 1) break; p = ii == 0 ? F.bid : 64 + F.bid; }
            else if (jj >= 16) { if (ii > 2) break; p = 64 + 64 + ((F.bid & 7) * 8 + (jj - 16)) + 64 * ii; }
            else break;
        } else { if (F.bid < 64) { if (ii) break; p = F.bid; } else { p = 64 + (F.bid - 64) + ii * (F.G - 64); if (p >= 64 + NPB * NDH) break; } }
        const bool samp = p < 64; const bool active = !samp || slot == 0;
        const int pp = samp ? p : p - 64, b = samp ? pp >> 4 : pp >> 3, h = samp ? (pp >> 1) & 7 : pp & 7, dir = samp ? pp & 1 : slot, n = samp ? TS / 64 : TP / 64;
        const size_t seqbase = samp ? (size_t)MP + (size_t)b * TS : (size_t)b * TP;
        f32x4 S[4];
        if (samp && active) { const float* s0 = F.in[5] + ((((size_t)b * DEPTH + l) * 2 + dir) * NDH + h) * 4096 + 16 * gw + l15 + (4 * q4) * 64;
#pragma unroll
            for (int dt = 0; dt < 4; ++dt) {
#pragma unroll
                for (int rg = 0; rg < 4; ++rg) S[dt][rg] = *(const GAS float*)(s0 + (16 * dt + rg) * 64);
                asm volatile("" ::: "memory"); } }
        else {
#pragma unroll
            for (int dt = 0; dt < 4; ++dt) S[dt] = (f32x4){0.f, 0.f, 0.f, 0.f}; }
        v4u kr[2], qr[2], vr[2], tr_[2]; float gr = 0.f;
#define D2_LOAD(s_) do { const int cidx_ = dir ? n - 1 - (s_) : (s_); const size_t tbn_ = seqbase + (size_t)64 * cidx_; \
        _Pragma("unroll") for (int k_ = 0; k_ < 2; ++k_) { const int pc_ = tg + 256 * k_, i_ = pc_ >> 3, c8_ = pc_ & 7; const bf16* rp_ = CONV + (tbn_ + (dir ? 63 - i_ : i_)) * CONVC + h * 64 + c8_ * 8; \
            qr[k_] = gld16_asm(rp_); kr[k_] = gld16_asm(rp_ + 512); vr[k_] = gld16_asm(rp_ + 1024); \
            tr_[k_] = gld16_asm(TPB + ((((tbn_ >> 6) * 2 + dir) * NDH + h) * 4096) + (size_t)pc_ * 8); } \
        if (tg < 64) gr = gld4_asm(LA + (tbn_ + (dir ? 63 - tg : tg)) * 16 + dir * 8 + h); } while (0)
#define D2_STORE() do { asm volatile("s_waitcnt vmcnt(0)" : "+v"(kr[0]), "+v"(kr[1]), "+v"(qr[0]), "+v"(qr[1]), "+v"(vr[0]), "+v"(vr[1]), "+v"(tr_[0]), "+v"(tr_[1]), "+v"(gr) :: "memory"); \
        _Pragma("unroll") for (int k_ = 0; k_ < 2; ++k_) { const int pc_ = tg + 256 * k_, i_ = pc_ >> 3, c8_ = pc_ & 7; \
            *(LAS v4u*)(KL + i_ * 144 + c8_ * 16) = kr[k_]; *(LAS v4u*)(QL + i_ * 144 + c8_ * 16) = qr[k_]; *(LAS v4u*)(VL + i_ * 144 + c8_ * 16) = vr[k_]; *(LAS v4u*)(TL + i_ * 144 + c8_ * 16) = tr_[k_]; } \
        if (tg < 64) GL[tg] = gr; } while (0)
        if (active) { D2_LOAD(0); D2_STORE(); }
        LBAR();
        for (int s = 0; s < n; ++s) {
            const size_t tb = seqbase + (size_t)64 * (dir ? n - 1 - s : s);
            if (active && s + 1 < n) D2_LOAD(s + 1);
            if (active) {
            { f32x4 a[4];
#pragma unroll
              for (int mt = 0; mt < 4; ++mt) a[mt] = (f32x4){0.f, 0.f, 0.f, 0.f};
#pragma unroll
              for (int ks = 0; ks < 2; ++ks) { const bx8 bq = *(const LAS bx8*)(QL + (16 * gw + l15) * 144 + (32 * ks + 8 * q4) * 2);
#pragma unroll
                  for (int mt = 0; mt < 4; ++mt) { const bx8 ak = *(const LAS bx8*)(KL + (16 * mt + l15) * 144 + (32 * ks + 8 * q4) * 2); a[mt] = __builtin_amdgcn_mfma_f32_16x16x32_bf16(ak, bq, a[mt], 0, 0, 0); } }
              const int c = 16 * gw + l15; const float gc = GL[c];
#pragma unroll
              for (int mt = 0; mt < 4; ++mt) { const f32x4 gj = *(const LAS f32x4*)(GL + 16 * mt + 4 * q4); f32x4 w;
#pragma unroll
                  for (int rg = 0; rg < 4; ++rg) { const int cj = 16 * mt + 4 * q4 + rg; w[rg] = (c >= cj) ? a[mt][rg] * __expf(gc - gj[rg]) : 0.f; }
                  *(LAS v2u*)(PL + c * 144 + (16 * mt + 4 * q4) * 2) = (v2u){pg8::cvt_pk_bf16(w[0], w[1]), pg8::cvt_pk_bf16(w[2], w[3])}; } }
            }
            LBAR();
            if (active) {
            { const float glast = GL[63]; f32x4 eg4[4];
#pragma unroll
              for (int ct = 0; ct < 4; ++ct) { const f32x4 g4 = *(const LAS f32x4*)(GL + 16 * ct + 4 * q4); eg4[ct] = (f32x4){__expf(g4[0]), __expf(g4[1]), __expf(g4[2]), __expf(g4[3])}; }
              const float egl = __expf(glast);
              const LAS unsigned char* vbase = VL + (4 * q4) * 144 + (16 * gw + l15) * 2;
              bx8 fa[4][2], fb[4][2];
#pragma unroll
              for (int ct = 0; ct < 4; ++ct) { fa[ct][0] = A_ROW(KL, 16 * ct + l15, 0); fa[ct][1] = A_ROW(KL, 16 * ct + l15, 1); }
#pragma unroll
              for (int ct = 0; ct < 4; ++ct) { fb[ct][0] = A_TRN(TL, ct, 0); fb[ct][1] = A_TRN(TL, ct, 1); }
              __builtin_amdgcn_sched_barrier(0);
              const bx8 sb0 = PACKB(S, 0), sb1 = PACKB(S, 1);
              f32x4 R[4];
#pragma unroll
              for (int ct = 0; ct < 4; ++ct) { f32x4 ksv = (f32x4){0.f, 0.f, 0.f, 0.f};
                  ksv = __builtin_amdgcn_mfma_f32_16x16x32_bf16(fa[ct][0], sb0, ksv, 0, 0, 0); ksv = __builtin_amdgcn_mfma_f32_16x16x32_bf16(fa[ct][1], sb1, ksv, 0, 0, 0);
#pragma unroll
                  for (int rg = 0; rg < 4; ++rg) R[ct][rg] = bf2f(*(const LAS unsigned short*)(vbase + (16 * ct + rg) * 144)) - eg4[ct][rg] * ksv[rg]; }
#pragma unroll
              for (int ct = 0; ct < 4; ++ct) { fa[ct][0] = A_ROW(QL, 16 * ct + l15, 0); fa[ct][1] = A_ROW(QL, 16 * ct + l15, 1); }
              __builtin_amdgcn_sched_barrier(0);
              const bx8 rb0 = PACKB(R, 0), rb1 = PACKB(R, 1);
              f32x4 U[4];
#pragma unroll
              for (int ct = 0; ct < 4; ++ct) { f32x4 u = (f32x4){0.f, 0.f, 0.f, 0.f};
                  u = __builtin_amdgcn_mfma_f32_16x16x32_bf16(fb[ct][0], rb0, u, 0, 0, 0); u = __builtin_amdgcn_mfma_f32_16x16x32_bf16(fb[ct][1], rb1, u, 0, 0, 0); U[ct] = u; }
#pragma unroll
              for (int ct = 0; ct < 4; ++ct) { fb[ct][0] = A_ROW(PL, 16 * ct + l15, 0); fb[ct][1] = A_ROW(PL, 16 * ct + l15, 1); }
              __builtin_amdgcn_sched_barrier(0);
              f32x4 O[4];
#pragma unroll
              for (int ct = 0; ct < 4; ++ct) { f32x4 o = (f32x4){0.f, 0.f, 0.f, 0.f};
                  o = __builtin_amdgcn_mfma_f32_16x16x32_bf16(fa[ct][0], sb0, o, 0, 0, 0); o = __builtin_amdgcn_mfma_f32_16x16x32_bf16(fa[ct][1], sb1, o, 0, 0, 0); O[ct] = o * eg4[ct]; }
#pragma unroll
              for (int dt = 0; dt < 4; ++dt) { fa[dt][0] = A_TRN(KL, dt, 0); fa[dt][1] = A_TRN(KL, dt, 1); }
              __builtin_amdgcn_sched_barrier(0);
              const bx8 ub0 = PACKB(U, 0), ub1 = PACKB(U, 1);
#pragma unroll
              for (int ct = 0; ct < 4; ++ct) { f32x4 o = O[ct];
                  o = __builtin_amdgcn_mfma_f32_16x16x32_bf16(fb[ct][0], ub0, o, 0, 0, 0); o = __builtin_amdgcn_mfma_f32_16x16x32_bf16(fb[ct][1], ub1, o, 0, 0, 0);
#pragma unroll
                  for (int rg = 0; rg < 4; ++rg) OL[(16 * ct + 4 * q4 + rg) * 68 + 16 * gw + l15] = o[rg]; }
#pragma unroll
              for (int ct = 0; ct < 4; ++ct) { const f32x4 g4 = *(const LAS f32x4*)(GL + 16 * ct + 4 * q4); U[ct] = U[ct] * (f32x4){__expf(glast - g4[0]), __expf(glast - g4[1]), __expf(glast - g4[2]), __expf(glast - g4[3])}; }
              const bx8 vb0 = PACKB(U, 0), vb1 = PACKB(U, 1);
#pragma unroll
              for (int dt = 0; dt < 4; ++dt) { f32x4 sn = S[dt] * egl;
                  sn = __builtin_amdgcn_mfma_f32_16x16x32_bf16(fa[dt][0], vb0, sn, 0, 0, 0); sn = __builtin_amdgcn_mfma_f32_16x16x32_bf16(fa[dt][1], vb1, sn, 0, 0, 0); S[dt] = sn; } }
            }
            LBAR();
            if (active) {
                if (s + 1 < n) D2_STORE();
                f32x4 o4[4];
#pragma unroll
                for (int k = 0; k < 4; ++k) o4[k] = *(const LAS f32x4*)(OL + orow_i * 68 + ocq + 4 * k);
                bf16* dst = (bf16*)TPB + ((((tb >> 6) * 2 + dir) * NDH + h) * 4096) + (size_t)(dir ? 63 - orow_i : orow_i) * 64 + ocq;
                *(GAS pg8::u32x4*)dst = pg8::pack8(o4[0], o4[1]); *(GAS pg8::u32x4*)(dst + 8) = pg8::pack8(o4[2], o4[3]);
            }
            LBAR();
        }
        if (!samp) { int q4b = q4, l15b = l15; asm volatile("" : "+v"(q4b), "+v"(l15b));
            float* dst = nst + ((((size_t)b * DEPTH + l) * 2 + dir) * NDH + h) * 4096 + 16 * gw + l15b + (4 * q4b) * 64;
#pragma unroll
            for (int dt = 0; dt < 4; ++dt)
#pragma unroll
                for (int rg = 0; rg < 4; ++rg) *(GAS float*)(dst + (16 * dt + rg) * 64) = S[dt][rg]; }
    }
#undef TRD
#undef A_ROW
#undef A_TRN
#undef PACKB
#undef D2_LOAD
#undef D2_STORE
#undef LBAR
}


__device__ __forceinline__ void ph_delta_combine(Frame& F, int l) {
    const bf16* TPB = (const bf16*)(F.ws + WS_H); const bf16* GOUT = (const bf16*)(F.ws + WS_GOUT); bf16* QO = (bf16*)(F.ws + WS_QO);
    const int c8 = F.tid & 7; const f32x4 g0 = *(const GAS f32x4*)(F.in[17] + l * 64 + c8 * 8), g1 = *(const GAS f32x4*)(F.in[17] + l * 64 + c8 * 8 + 4);
    for (int u = F.bid * (NTHREADS / 8) + (F.tid >> 3); u < M * NDH; u += F.G * (NTHREADS / 8)) {
        const int row = u >> 3, h = u & 7, ck = row >> 6, t = row & 63;
        const bf16* pf = TPB + ((((size_t)ck * 2 + 0) * NDH + h) * 64 + t) * 64 + c8 * 8; const bf16* pb = pf + (size_t)NDH * 4096;
        f32x4 a0, a1, b0, b1, s0, s1; pg8::unpack8(*(const GAS pg8::u32x4*)pf, a0, a1); pg8::unpack8(*(const GAS pg8::u32x4*)pb, b0, b1);
        pg8::unpack8(*(const GAS pg8::u32x4*)(GOUT + (size_t)row * 512 + h * 64 + c8 * 8), s0, s1);
        a0 = a0 + b0; a1 = a1 + b1;
        float ss = (a0[0] * a0[0] + a0[1] * a0[1]) + (a0[2] * a0[2] + a0[3] * a0[3]) + (a1[0] * a1[0] + a1[1] * a1[1]) + (a1[2] * a1[2] + a1[3] * a1[3]);
        ss += shx(ss, 1, F.lane); ss += shx(ss, 2, F.lane); ss += shx(ss, 4, F.lane);
        const float rstd = __builtin_amdgcn_rsqf(ss * (1.f / 64.f) + EPS);
        *(GAS pg8::u32x4*)(QO + (size_t)row * D + 512 + h * 64 + c8 * 8) = pg8::pack8(a0 * rstd * g0 * s0, a1 * rstd * g1 * s1);
    }
}
__global__ void __launch_bounds__(NTHREADS, 2) mk_fwd(Args args) {
    extern __shared__ __attribute__((aligned(16))) unsigned char lds[];
    Frame F;
    F.lds = (LAS unsigned char*)lds; F.tid = threadIdx.x; F.lane = F.tid & 63; F.wave = __builtin_amdgcn_readfirstlane(F.tid >> 6); F.G = gridDim.x; F.bid = blockIdx.x;
    const int wave0 = F.wave;
    F.in = args.in; F.out = args.out; F.ws = args.ws;
    volatile LAS unsigned* MISC = (volatile LAS unsigned*)(F.lds + MISC_OFF);
    if (F.tid < 32) MISC[F.tid] = 0u;
    __syncthreads();
    XcdBarrier bar; bar.bar = (unsigned*)(F.ws + WS_CTL) + CW_BAR; bar.x = 0; bar.st = nullptr;
#if MK_ONE_LAUNCH
    bar = xcd_barrier_post((unsigned*)(F.ws + WS_CTL) + CW_BAR, MISC + 8);
#endif
    const int lo = args.ph_lo, hi = args.ph_hi; int ph = 0;
#define REFRESH() do { int t_; asm volatile("v_mbcnt_lo_u32_b32 %0, -1, 0\n\tv_mbcnt_hi_u32_b32 %0, -1, %0" : "=v"(t_)); t_ += wave0 * 64; F.tid = t_; F.lane = t_ & 63; F.wave = __builtin_amdgcn_readfirstlane(t_ >> 6); \
        unsigned char* w_ = args.ws; asm volatile("" : "+s"(w_)); F.ws = w_; float* o_ = args.out; asm volatile("" : "+s"(o_)); F.out = o_; } while (0)
#if MK_ONE_LAUNCH
#define PHASE(body) do { REFRESH(); body; bar.bar = (unsigned*)(F.ws + WS_CTL) + CW_BAR; xcd_barrier(bar, F.tid); ++ph; } while (0)
#else
#define PHASE(body) do { if (ph >= lo && ph < hi) { REFRESH(); body; } ++ph; } while (0)
#endif
    PHASE(ph_prologue(F); ph_convert_weights(F, 0));
    for (int l = 0; l < DEPTH; ++l) {
        if (l == 0) PHASE(ph_modnorm(F, l, 0, true); ph_sb1(F));
        else PHASE(ph_convert_weights(F, l); ph_modnorm(F, l, 0, false));
        PHASE(ph_projA(F, l));
        PHASE(ph_delta_pre(F, l));
        PHASE(ph_delta_scan(F, l); attn_units(F, (char*)lds));
        PHASE(ph_delta_combine(F, l));
        PHASE(ph_modnorm(F, l, 0, l == 0));
        PHASE(ph_gates(F));
        PHASE(ph_merge(F));
        PHASE(ph_outproj(F, l, l == 0));
        PHASE(ph_ffn1(F, l, 0, M / 2));
        PHASE(ph_resid_gemm(F, l, F.ws + WS_FF, FF, F.ws + WS_W + W_2, F.in[24] + l * D, 5, 0, M / 2, false));
        PHASE(ph_ffn1(F, l, M / 2, M / 2));
        PHASE(ph_resid_gemm(F, l, F.ws + WS_FF, FF, F.ws + WS_W + W_2, F.in[24] + l * D, 5, M / 2, M / 2, false));
    }
    PHASE(ph_final_norm(F));
}
constexpr int N_PHASES = 1 + DEPTH * 13 + 1;

extern "C" void kernel_launch(void* const* d_in, const int* in_sizes, int n_in, void* d_out, int out_size, void* d_ws, size_t ws_size, hipStream_t stream) {
    static int grid = 0;
    if (grid == 0) {
        if (n_in != 26 || ws_size < WS_END) { fprintf(stderr, "kernel_launch: unexpected n_in %d / ws %zu\n", n_in, ws_size); grid = -1; return; }
        int dev = 0, cus = 0;
        if (hipGetDevice(&dev) != hipSuccess || hipDeviceGetAttribute(&cus, hipDeviceAttributeMultiprocessorCount, dev) != hipSuccess) { grid = -1; return; }
        if (hipFuncSetAttribute((const void*)mk_fwd, hipFuncAttributeMaxDynamicSharedMemorySize, LDS_BYTES) != hipSuccess) { grid = -1; return; }
        int per_cu = 0;
        if (hipOccupancyMaxActiveBlocksPerMultiprocessor(&per_cu, (const void*)mk_fwd, NTHREADS, LDS_BYTES) != hipSuccess || per_cu < 1) { fprintf(stderr, "kernel_launch: occupancy query says %d blocks per CU\n", per_cu); grid = -1; return; }
        (void)hipGetLastError();
        grid = cus;
    }
    if (grid < 0) return;
    (void)hipMemsetAsync((char*)d_ws + WS_CTL, 0, CTL_ZERO_BYTES, stream);
    Args a{};
    for (int i = 0; i < 26; ++i) a.in[i] = (const float*)d_in[i];
    a.out = (float*)d_out; a.ws = (unsigned char*)d_ws;
#if MK_ONE_LAUNCH
    a.ph_lo = 0; a.ph_hi = N_PHASES;
    void* kargs[] = {&a};
    hipError_t e = hipLaunchCooperativeKernel((const void*)mk_fwd, dim3(grid), dim3(NTHREADS), kargs, LDS_BYTES, stream);
    if (e != hipSuccess) fprintf(stderr, "kernel_launch: cooperative launch failed: %s (grid %d)\n", hipGetErrorString(e), grid);
#else
    for (int p = 0; p < N_PHASES; ++p) { a.ph_lo = p; a.ph_hi = p + 1; hipLaunchKernelGGL(mk_fwd, dim3(grid), dim3(NTHREADS), LDS_BYTES, stream, a); }
#endif
}
```

```cpp
#include <hip/hip_runtime.h>
#include <cstdio>
#include <cstdint>

#ifndef MK_ONE_LAUNCH
#define MK_ONE_LAUNCH 1
#endif

constexpr int D = 1024, NPB = 32, TP = 256, NSB = 4, TS = 4096, PAST = 256, DEPTH = 2;
constexpr int MP = NPB * TP, MS = NSB * TS, M = MP + MS;
constexpr int NQH = 8, NKVH = 2, HD = 64, NDH = 8;
constexpr int INW = 4896, NA = 2848, NA_PAD = 3072, NG = 2048, FF = 4096, CONVC = 1536;
constexpr int KEYS_S = PAST + TS;
constexpr float EPS = 1e-6f;
constexpr float C2 = 0.125f * 1.4426950408889634f;
constexpr int NWAVES = 8, NTHREADS = 512;

constexpr size_t MiB = 1u << 20;
constexpr size_t WS_CTL = 0, CTL_ZERO_BYTES = 1 * MiB;
constexpr size_t WS_MOD = 1 * MiB;
constexpr size_t WS_ROPE = 2 * MiB;
constexpr size_t WS_W = 3 * MiB;
constexpr size_t W_INA = 0, W_ING = 6 * MiB, W_P = 10 * MiB, W_OUT = 12 * MiB, W_1 = 14 * MiB, W_2 = 22 * MiB;
constexpr size_t WS_H = 33 * MiB;
constexpr size_t WS_QO = 81 * MiB;
constexpr size_t WS_R4 = 129 * MiB;
constexpr size_t WS_KP = WS_R4, WS_VP = WS_R4 + 2 * MiB, WS_KS = WS_R4 + 4 * MiB, WS_VS = WS_R4 + 9 * MiB;
constexpr size_t WS_LA = WS_R4 + 14 * MiB, WS_BETA = WS_R4 + 16 * MiB;
constexpr size_t WS_GOUT = WS_R4 + 18 * MiB;
constexpr size_t WS_CONV = WS_R4 + 42 * MiB;
constexpr size_t WS_BND = WS_R4 + 114 * MiB;
constexpr size_t WS_GATES = WS_R4;
constexpr size_t WS_FF = WS_R4;
constexpr size_t WS_END = 256 * MiB;
static_assert(WS_CONV + (size_t)M * CONVC * 2 <= WS_END && WS_GATES + (size_t)M * NG * 2 <= WS_END && WS_FF + (size_t)(M / 2) * FF * 2 <= WS_END, "ws map");

constexpr int CW_BAR = 4096;
constexpr size_t CTL_SUMSQ2 = 256 * 1024;
constexpr size_t WS_SB1 = WS_MOD + 512 * 1024;

#define GAS __attribute__((address_space(1)))
#define LAS __attribute__((address_space(3)))
typedef unsigned short bf16;
typedef unsigned v4u __attribute__((ext_vector_type(4)));
typedef unsigned v2u __attribute__((ext_vector_type(2)));
typedef float f32x4 __attribute__((ext_vector_type(4)));
#define RLX_AGENT __ATOMIC_RELAXED, __HIP_MEMORY_SCOPE_AGENT
__device__ __forceinline__ unsigned f2bf(float f) { unsigned u = __builtin_bit_cast(unsigned, f); return (u + 0x7fffu + ((u >> 16) & 1u)) >> 16; }
__device__ __forceinline__ unsigned pk2(float lo, float hi) { return f2bf(lo) | (f2bf(hi) << 16); }
__device__ __forceinline__ float bf2f(unsigned short b) { return __builtin_bit_cast(float, (unsigned)b << 16); }
__device__ __forceinline__ float bflo(unsigned w) { return __builtin_bit_cast(float, w << 16); }
__device__ __forceinline__ float bfhi(unsigned w) { return __builtin_bit_cast(float, w & 0xffff0000u); }
__device__ __forceinline__ float sigmoidf_(float x) { return 1.f / (1.f + __expf(-x)); }
__device__ __forceinline__ float siluf_(float x) { return x / (1.f + __expf(-x)); }
__device__ __forceinline__ float shx(float v, int mask, int lane) { return __builtin_bit_cast(float, __builtin_amdgcn_ds_bpermute((lane ^ mask) << 2, __builtin_bit_cast(int, v))); }
__device__ __forceinline__ float shl_from(float v, int src_lane) { return __builtin_bit_cast(float, __builtin_amdgcn_ds_bpermute((src_lane & 63) << 2, __builtin_bit_cast(int, v))); }
__device__ __forceinline__ float wave_sum(float v, int lane) {
#pragma unroll
    for (int o = 1; o < 64; o <<= 1) v += shx(v, o, lane);
    return v;
}

#define XB_TMO      128
#define XB_XCNT(j)  (256  + 64 * (j))
#define XB_XSUB(j)  (1280 + 64 * (j))
#define XB_XGEN(j)  (2304 + 64 * (j))
#define XB_TOP      3328
#define XB_TOPGEN   3392
#define XCD_BAR_WORDS 3456
#define XB_SPIN_CAP (1u << 25)
__device__ __forceinline__ unsigned xb_ld(unsigned* p)              { return __hip_atomic_load((GAS unsigned*)p, __ATOMIC_RELAXED, __HIP_MEMORY_SCOPE_AGENT); }
__device__ __forceinline__ unsigned xb_add(unsigned* p, unsigned v) { return __hip_atomic_fetch_add((GAS unsigned*)p, v, __ATOMIC_RELAXED, __HIP_MEMORY_SCOPE_AGENT); }
__device__ __forceinline__ unsigned xb_xcc_id() { return (unsigned)__builtin_amdgcn_s_getreg((3 << 11) | 20) & 0xFu; }
#define XB_SPIN(cond, bar) do { unsigned _sp = 0; while (cond) { __builtin_amdgcn_s_sleep(1); \
    if ((++_sp & 255u) == 0u) { if (xb_ld(&(bar)[XB_TMO])) break; if (_sp > XB_SPIN_CAP) { xb_add(&(bar)[XB_TMO], 1u); break; } } } } while (0)
struct XcdBarrier { unsigned* bar; unsigned x; volatile LAS unsigned* st; };
__device__ __forceinline__ XcdBarrier xcd_barrier_post(unsigned* bar, volatile LAS unsigned* st) {
    XcdBarrier b; b.bar = bar; b.x = xb_xcc_id(); b.st = st;
    if (threadIdx.x == 0) (void)xb_add(&bar[XB_XCNT(b.x)], 1u);
    return b;
}
__device__ __forceinline__ void xcd_barrier_complete(unsigned* bar, unsigned x, unsigned& nloc, unsigned& nx) {
    const unsigned G = gridDim.x * gridDim.y * gridDim.z;
    unsigned sum, cnt, mine, sp = 0u;
    for (;;) {
        sum = 0u; cnt = 0u; mine = 0u;
#pragma unroll
        for (unsigned j = 0; j < 16; ++j) { const unsigned c = xb_ld(&bar[XB_XCNT(j)]); sum += c; cnt += (c > 0u) ? 1u : 0u; mine = (j == x) ? c : mine; }
        if (sum == G) break;
        __builtin_amdgcn_s_sleep(1);
        if ((++sp & 255u) == 0u) { if (xb_ld(&bar[XB_TMO])) break; if (sp > XB_SPIN_CAP) { xb_add(&bar[XB_TMO], 1u); break; } }
    }
    nloc = mine > 0u ? mine : 1u; nx = cnt > 0u ? cnt : 1u;
}
__device__ __forceinline__ void xcd_barrier(const XcdBarrier& b_, const int tid) {
    asm volatile("s_waitcnt vmcnt(0)" ::: "memory");
    __syncthreads();
    if (tid == 0) {
        XcdBarrier b; b.st = b_.st; { unsigned* p = b_.bar; asm volatile("" : "+s"(p)); b.bar = p; } b.x = (unsigned)__builtin_amdgcn_readfirstlane((int)xb_xcc_id());
        unsigned* bar = b.bar;
        __builtin_amdgcn_s_waitcnt(0);
        unsigned nloc = b.st[0], nx = b.st[1];
        if (nloc == 0u) { xcd_barrier_complete(bar, b.x, nloc, nx); b.st[0] = nloc; b.st[1] = nx; }
        const unsigned old = xb_add(&bar[XB_XSUB(b.x)], 1u);
        const unsigned gen = old / nloc;
        if (old + 1u == (gen + 1u) * nloc) {
            __builtin_amdgcn_fence(__ATOMIC_RELEASE, "agent");
            asm volatile("s_waitcnt vmcnt(0)" ::: "memory");
            const unsigned og = xb_add(&bar[XB_TOP], 1u);
            const unsigned tg = og / nx;
            if (og + 1u == (tg + 1u) * nx) xb_add(&bar[XB_TOPGEN], 1u);
            else XB_SPIN(xb_ld(&bar[XB_TOPGEN]) == tg, bar);
            __builtin_amdgcn_fence(__ATOMIC_ACQUIRE, "agent");
            xb_add(&bar[XB_XGEN(b.x)], 1u);
            asm volatile("s_waitcnt vmcnt(0)" ::: "memory");
        } else {
            XB_SPIN(xb_ld(&bar[XB_XGEN(b.x)]) == gen, bar);
            __builtin_amdgcn_fence(__ATOMIC_ACQUIRE, "agent");
            asm volatile("s_waitcnt vmcnt(0)" ::: "memory");
        }
    }
    __syncthreads();
}

constexpr int LDS_BYTES = 147456;
constexpr int MISC_OFF = 131072 + 320;
struct Args { const float* in[26]; float* out; unsigned char* ws; int ph_lo, ph_hi; };
struct Frame {
    LAS unsigned char* lds;
    int tid, lane, wave, G, bid;
    const float* const* in; float* out; unsigned char* ws;
};
__device__ __forceinline__ int mod_index(int row) { return row < MP ? 0 : 1 + (row - MP) / TS; }
__device__ __forceinline__ const float* mod_ptr(const Frame& F, int l, int row, int part) { return (const float*)(F.ws + WS_MOD) + ((size_t)(l * 5 + mod_index(row)) * 6 + part) * D; }

__device__ __forceinline__ void transpose_item(const float* W, int ldw, int c0, int ncols, int K, bf16* WT, int row_off, LAS float* scr, int item, int lane) {
    const int nblk = ncols / 32, kb = item / nblk, nb = item % nblk, k0 = 64 * kb, n0 = 32 * nb;
#pragma unroll 8
    for (int i = 0; i < 32; ++i) { const int kk = 2 * i + (lane >> 5); scr[kk * 33 + (lane & 31)] = W[(size_t)(k0 + kk) * ldw + c0 + n0 + (lane & 31)]; }
    asm volatile("s_waitcnt lgkmcnt(0)" ::: "memory");
    const int c = lane & 7;
#pragma unroll
    for (int j = 0; j < 4; ++j) { const int n = (lane >> 3) + 8 * j; const LAS float* s = scr + (8 * c) * 33 + n;
        v4u o; o.x = pk2(s[0 * 33], s[1 * 33]); o.y = pk2(s[2 * 33], s[3 * 33]); o.z = pk2(s[4 * 33], s[5 * 33]); o.w = pk2(s[6 * 33], s[7 * 33]);
        *(GAS v4u*)(WT + (size_t)(row_off + n0 + n) * K + k0 + 8 * c) = o; }
    asm volatile("s_waitcnt lgkmcnt(0)" ::: "memory");
}
__device__ __forceinline__ void ph_convert_weights(Frame& F, int l, int mode, int nw, int c) {
    LAS float* scr = (LAS float*)(F.lds + F.wave * 16384);
    const int gw = c * NWAVES + F.wave, NGW = nw * NWAVES;
    unsigned char* wb = F.ws + WS_W;
    const float* w_in = F.in[11] + (size_t)l * D * INW; const float* w_pa = F.in[18] + (size_t)l * 512 * D; const float* w_pd = F.in[19] + (size_t)l * 512 * D;
    const float* w_out = F.in[20] + (size_t)l * D * D; const float* w1 = F.in[21] + (size_t)l * D * FF; const float* w2 = F.in[23] + (size_t)l * FF * D;
    constexpr int I_A = (D / 64) * (NA / 32), I_G = (D / 64) * (NG / 32), I_P = (512 / 64) * (D / 32), I_O = (D / 64) * (D / 32), I_1 = (D / 64) * (FF / 32), I_2 = (FF / 64) * (D / 32);
    constexpr int NITEMS = I_A + I_G + 2 * I_P + I_O + I_1 + I_2;
    const int it_lo = mode == 2 ? NITEMS - I_2 : 0, it_hi = mode == 1 ? NITEMS - I_2 : NITEMS;
    for (int it = it_lo + gw; it < it_hi; it += NGW) {
        int r = it; const float* W; int ldw, c0, ncols, K; bf16* WT;
        if (r < I_A) { W = w_in; ldw = INW; c0 = 0; ncols = NA; K = D; WT = (bf16*)(wb + W_INA); }
        else if ((r -= I_A) < I_G) { W = w_in; ldw = INW; c0 = NA; ncols = NG; K = D; WT = (bf16*)(wb + W_ING); }
        else if ((r -= I_G) < I_P) { W = w_pa; ldw = D; c0 = 0; ncols = D; K = 512; WT = (bf16*)(wb + W_P); }
        else if ((r -= I_P) < I_P) { W = w_pd; ldw = D; c0 = 0; ncols = D; K = 512; WT = (bf16*)(wb + W_P) + (size_t)D * 512; }
        else if ((r -= I_P) < I_O) { W = w_out; ldw = D; c0 = 0; ncols = D; K = D; WT = (bf16*)(wb + W_OUT); }
        else if ((r -= I_O) < I_1) { W = w1; ldw = FF; c0 = 0; ncols = FF; K = D; WT = (bf16*)(wb + W_1); }
        else { r -= I_1; W = w2; ldw = D; c0 = 0; ncols = D; K = FF; WT = (bf16*)(wb + W_2); }
        transpose_item(W, ldw, c0, ncols, K, WT, 0, scr, r, F.lane);
    }
    if (mode == 1) return;
    { v4u* p = (v4u*)((bf16*)(wb + W_INA) + (size_t)NA * D); const int n16 = (NA_PAD - NA) * D * 2 / 16;
      unsigned zz = 0u; asm volatile("" : "+v"(zz));
      for (int i = F.bid * NTHREADS + F.tid; i < n16; i += F.G * NTHREADS) p[i] = (v4u){zz, zz, zz, zz}; }
    { const float* ck = F.in[3]; const float* cv = F.in[4]; bf16* KS = (bf16*)(F.ws + WS_KS); bf16* VS = (bf16*)(F.ws + WS_VS);
      const int n = NSB * PAST * 128;
      for (int i = F.bid * NTHREADS + F.tid; i < n; i += F.G * NTHREADS) { const int d = i & 63, kvh = (i >> 6) & 1, j = (i >> 7) & 255, b = i >> 15;
          const size_t src = ((((size_t)b * DEPTH + l) * NKVH + kvh) * PAST + j) * HD + d; const size_t dst = ((size_t)b * KEYS_S + j) * 128 + kvh * 64 + d;
          KS[dst] = (bf16)f2bf(ck[src]); VS[dst] = (bf16)f2bf(cv[src]); } }
}
__device__ __forceinline__ void ph_prologue(Frame& F) {
    { float* rc = (float*)(F.ws + WS_ROPE); float* rs = rc + TS * 32;
      for (int i = F.bid * NTHREADS + F.tid; i < TS * 32; i += F.G * NTHREADS) { const int t = i >> 5, f = i & 31;
          const float inv = powf(10000.0f, -(float)(f & 15) / 16.0f); const float pos = (f < 16) ? (float)(t >> 6) : (float)(t & 63); const float ang = pos * inv;
          rc[i] = cosf(ang); rs[i] = sinf(ang); } }
    { LAS float* sc = (LAS float*)F.lds;
      LAS float* red = sc + 5 * D;
      for (int i = F.tid; i < 5 * D; i += NTHREADS) { const int j = i / D, k = i % D; const float v = j == 0 ? F.in[6][k] : F.in[2][(j - 1) * D + k]; sc[i] = siluf_(v); }
      __syncthreads();
      for (int it = F.bid; it < DEPTH * 96; it += F.G) { const int l = it / 96, n0 = (it % 96) * 64;
          const float* w = F.in[7] + (size_t)l * D * 6144 + n0 + F.lane; float acc[5] = {0.f, 0.f, 0.f, 0.f, 0.f};
          for (int k = F.wave * 128; k < F.wave * 128 + 128; ++k) { const float wv = w[(size_t)k * 6144];
#pragma unroll
              for (int j = 0; j < 5; ++j) acc[j] += sc[j * D + k] * wv; }
#pragma unroll
          for (int j = 0; j < 5; ++j) red[(F.wave * 5 + j) * 64 + F.lane] = acc[j];
          __syncthreads();
          if (F.tid < 320) { const int j = F.tid / 64, n = F.tid % 64; float s = F.in[8][l * 6144 + n0 + n];
              for (int w8 = 0; w8 < 8; ++w8) s += red[(w8 * 5 + j) * 64 + n];
              ((float*)(F.ws + WS_MOD))[(size_t)(l * 5 + j) * 6144 + n0 + n] = s; }
          __syncthreads(); } }
}
__device__ __forceinline__ void ph_modnorm(Frame& F, int l, int which  , bool from_inputs) {
    const float* g = F.in[which ? 10 : 9] + l * D; bf16* H = (bf16*)(F.ws + WS_H);
    const int gw = F.bid * NWAVES + F.wave, NGW = F.G * NWAVES;
    for (int m = gw; m < M; m += NGW) {
        const float* xrow = from_inputs ? (m < MP ? F.in[0] + (size_t)m * D : F.in[1] + (size_t)(m - MP) * D) : F.out + (size_t)m * D;
        const f32x4* xr = (const f32x4*)xrow + F.lane;
        const f32x4* sh = (const f32x4*)mod_ptr(F, l, m, which ? 3 : 0) + F.lane; const f32x4* scp = (const f32x4*)mod_ptr(F, l, m, which ? 4 : 1) + F.lane; const f32x4* gp = (const f32x4*)g + F.lane;
        f32x4 v[4]; float s = 0.f;
#pragma unroll
        for (int j = 0; j < 4; ++j) { v[j] = xr[64 * j]; s += (v[j].x * v[j].x + v[j].y * v[j].y) + (v[j].z * v[j].z + v[j].w * v[j].w); }
        const float rstd = 1.f / sqrtf(wave_sum(s, F.lane) * (1.f / D) + EPS);
        v2u* o8 = (v2u*)(H + (size_t)m * D) + F.lane;
#pragma unroll
        for (int j = 0; j < 4; ++j) { const f32x4 gg = gp[64 * j], s1 = scp[64 * j], s0 = sh[64 * j]; const f32x4 y = v[j] * rstd * gg * (s1 + 1.f) + s0;
            v2u w; w.x = pk2(y.x, y.y); w.y = pk2(y.z, y.w); o8[64 * j] = w; }
    }
}
__device__ __forceinline__ void ph_final_norm(Frame& F) {
    const float* g = F.in[25]; const int gw = F.bid * NWAVES + F.wave, NGW = F.G * NWAVES;
    for (int m = gw; m < M; m += NGW) {
        f32x4* xr = (f32x4*)(F.out + (size_t)m * D) + F.lane; const f32x4* gp = (const f32x4*)g + F.lane;
        f32x4 v[4]; float s = 0.f;
#pragma unroll
        for (int j = 0; j < 4; ++j) { v[j] = xr[64 * j]; s += (v[j].x * v[j].x + v[j].y * v[j].y) + (v[j].z * v[j].z + v[j].w * v[j].w); }
        const float rstd = 1.f / sqrtf(wave_sum(s, F.lane) * (1.f / D) + EPS);
#pragma unroll
        for (int j = 0; j < 4; ++j) xr[64 * j] = v[j] * rstd * gp[64 * j];
    }
}

namespace pg8 {
#define PG8_LAS __attribute__((address_space(3)))
typedef unsigned short bf16_t;
typedef short bf16x8 __attribute__((ext_vector_type(8)));
typedef unsigned u32x4 __attribute__((ext_vector_type(4)));
constexpr int BM = 256, BK = 64, HALF = 128, HTB = HALF * BK * 2, NXCD = 8, WGM = 8;
__host__ __device__ __forceinline__ int lds_byte(int r, int c) { const int st = (r >> 4) * 2 + (c >> 5), rr = r & 15, cc = c & 31, ob = rr * 64 + cc * 2; return st * 1024 + (ob ^ (((ob >> 9) & 1) << 5)); }
__host__ __device__ __forceinline__ void stage_rc(int b, int& R, int& C) { const int st = b / 1024, sb = b % 1024, swz = sb ^ (((sb >> 9) & 1) << 5); R = (st >> 1) * 16 + swz / 64; C = (st & 1) * 32 + (swz % 64) / 2; }
__host__ __device__ __forceinline__ int perm32(int rho) { const int n = rho >> 4, i = rho & 15; return 8 * (i >> 2) + 4 * n + (i & 3); }
struct Unit { int pm, pn, part; const char* a; const char* b; };
struct Shape { int lda, ldb, nt; };
struct TileOrder {
    int nM, nN, nwg, G, c; const char* A; const char* B; size_t at, bt;
    __device__ void init(int nM_, int nN_, int G_, int c_, const void* A_, size_t at_, const void* B_, size_t bt_) { nM = nM_; nN = nN_; nwg = nM * nN; G = G_; c = c_; A = (const char*)A_; B = (const char*)B_; at = at_; bt = bt_; }
    __device__ bool tile(int i, int& pm, int& pn) const {
        const long L = (long)i * G + c; if (L >= nwg) return false;
        int wgid = (int)L; { const int q = nwg / NXCD, r = nwg % NXCD, xcd = wgid % NXCD, off = wgid / NXCD; wgid = (xcd < r ? xcd * (q + 1) : r * (q + 1) + (xcd - r) * q) + off; }
        const int nig = WGM * nN, gid = wgid / nig, fm = gid * WGM, gsz = (nM - fm) < WGM ? (nM - fm) : WGM;
        pm = fm + ((wgid % nig) % gsz); pn = (wgid % nig) / gsz; return true;
    }
    __device__ bool next(int i, Unit& u) const { if (!tile(i, u.pm, u.pn)) return false; u.part = 1; u.a = A + (size_t)u.pm * at; u.b = B + (size_t)u.pn * bt; return true; }
};
struct SplitAOrder : TileOrder {
    const char* A_lo; int split;
    __device__ bool next(int i, Unit& u) const { if (!tile(i, u.pm, u.pn)) return false; u.part = 1; u.a = (u.pm < split ? A_lo : A) + (size_t)u.pm * at; u.b = B + (size_t)u.pn * bt; return true; }
};
struct TwoPartOrder : TileOrder {
    const char* B1; size_t apart;
    __device__ bool next(int i, Unit& u) const { if (!tile(i >> 1, u.pm, u.pn)) return false; u.part = i & 1; u.a = A + (size_t)u.pm * at + (u.part ? apart : 0); u.b = (u.part ? B1 : B) + (size_t)u.pn * bt; return true; }
};
typedef float f32x2_t __attribute__((ext_vector_type(2))); typedef __bf16 bf16x2_t __attribute__((ext_vector_type(2)));
__device__ __forceinline__ unsigned cvt_pk_bf16(float lo, float hi) { f32x2_t v = {lo, hi}; bf16x2_t b = __builtin_convertvector(v, bf16x2_t); return __builtin_bit_cast(unsigned, b); }
__device__ __forceinline__ u32x4 pack8(const f32x4& a, const f32x4& b) { u32x4 w; w.x = cvt_pk_bf16(a[0], a[1]); w.y = cvt_pk_bf16(a[2], a[3]); w.z = cvt_pk_bf16(b[0], b[1]); w.w = cvt_pk_bf16(b[2], b[3]); return w; }
__device__ __forceinline__ void unpack8(const u32x4 w, f32x4& a, f32x4& b) { a = (f32x4){bflo(w.x), bfhi(w.x), bflo(w.y), bfhi(w.y)}; b = (f32x4){bflo(w.z), bfhi(w.z), bflo(w.w), bfhi(w.w)}; }
__device__ __forceinline__ float fsig(float x) { return __builtin_amdgcn_rcpf(1.f + __builtin_amdgcn_exp2f(-1.4426950408889634f * x)); }
__device__ __forceinline__ f32x4 fsig4(const f32x4& x) { return (f32x4){fsig(x[0]), fsig(x[1]), fsig(x[2]), fsig(x[3])}; }

struct EpiGates { static constexpr int BMAP = 1; static constexpr bool STAGGER = true; bf16_t* O;
    __device__ __forceinline__ void operator()(f32x4 (&acc)[2][2][4][2], const Unit& u, int wr, int wc, int fr, int fq) const {
        bf16_t* base = O + (size_t)(u.pm * BM + wr * 64 + fr) * NG + u.pn * BM + wc * 32 + 8 * fq;
#pragma unroll
        for (int ai = 0; ai < 2; ++ai)
#pragma unroll
            for (int m = 0; m < 4; ++m)
#pragma unroll
                for (int bj = 0; bj < 2; ++bj) *(GAS u32x4*)(base + (size_t)(ai * HALF + m * 16) * NG + bj * HALF) = pack8(fsig4(acc[ai][bj][m][0]), fsig4(acc[ai][bj][m][1]));
    }
};
struct EpiFfn1 { static constexpr int BMAP = 1; static constexpr bool STAGGER = true; bf16_t* O; const float* sb1; const float* sumsq; int row_off;
    __device__ __forceinline__ void operator()(f32x4 (&acc)[2][2][4][2], const Unit& u, int wr, int wc, int fr, int fq) const {
        const int col0 = u.pn * BM + wc * 32 + 8 * fq, rowt = row_off + u.pm * BM; bf16_t* base = O + (size_t)(u.pm * BM + wr * 64 + fr) * FF + col0;
        const float* bp = sb1 + (size_t)mod_index(rowt) * FF + col0;
        f32x4 bv[2][2];
#pragma unroll
        for (int bj = 0; bj < 2; ++bj)
#pragma unroll
            for (int n = 0; n < 2; ++n) bv[bj][n] = *(const GAS f32x4*)(bp + bj * HALF + 4 * n);
        float ssq[8];
#pragma unroll
        for (int i = 0; i < 8; ++i) ssq[i] = *(const GAS float*)(sumsq + rowt + (i >> 2) * HALF + wr * 64 + (i & 3) * 16 + fr);
#pragma unroll
        for (int ai = 0; ai < 2; ++ai)
#pragma unroll
            for (int m = 0; m < 4; ++m) { const float rstd = __builtin_amdgcn_rsqf(ssq[ai * 4 + m] * (1.f / D) + EPS);
#pragma unroll
                for (int bj = 0; bj < 2; ++bj) { f32x4 v0 = acc[ai][bj][m][0] * rstd + bv[bj][0], v1 = acc[ai][bj][m][1] * rstd + bv[bj][1];
                    v0 = __builtin_elementwise_max(v0, (f32x4){0.f, 0.f, 0.f, 0.f}); v1 = __builtin_elementwise_max(v1, (f32x4){0.f, 0.f, 0.f, 0.f});
                    *(GAS u32x4*)(base + (size_t)(ai * HALF + m * 16) * FF + bj * HALF) = pack8(v0 * v0, v1 * v1); } }
    }
};
struct EpiResid { static constexpr int BMAP = 0; static constexpr bool STAGGER = false; float* X; const float* bias; const float* modl; int gate_part, row_off; const float* xp; const float* xs;
    __device__ __forceinline__ void operator()(f32x4 (&acc)[2][2][4][2], const Unit& u, int wr, int wc, int fr, int fq) const {
        const int col0 = u.pn * BM + wc * 32 + 4 * fq, rowt = row_off + u.pm * BM;
        const float* gp = modl + ((size_t)mod_index(rowt) * 6 + gate_part) * D + col0;
        f32x4 gv[2][2], bv[2][2];
#pragma unroll
        for (int bj = 0; bj < 2; ++bj)
#pragma unroll
            for (int n = 0; n < 2; ++n) { gv[bj][n] = *(const GAS f32x4*)(gp + bj * HALF + n * 16); bv[bj][n] = bias ? *(const GAS f32x4*)(bias + col0 + bj * HALF + n * 16) : (f32x4){0.f, 0.f, 0.f, 0.f}; }
#pragma unroll
        for (int q = 0; q < 4; ++q) { const int ai = q >> 1, m0 = (q & 1) * 2; f32x4 xv[2][2][2];
#pragma unroll
            for (int mm = 0; mm < 2; ++mm) { const size_t ro = (size_t)(rowt + ai * HALF + wr * 64 + (m0 + mm) * 16 + fr) * D + col0; const float* xi = xp ? (rowt < MP ? xp + ro : xs + (ro - (size_t)MP * D)) : X + ro;
#pragma unroll
                for (int bj = 0; bj < 2; ++bj)
#pragma unroll
                    for (int n = 0; n < 2; ++n) xv[mm][bj][n] = *(const GAS f32x4*)(xi + bj * HALF + n * 16); }
#pragma unroll
            for (int mm = 0; mm < 2; ++mm) { float* xr = X + (size_t)(rowt + ai * HALF + wr * 64 + (m0 + mm) * 16 + fr) * D + col0;
#pragma unroll
                for (int bj = 0; bj < 2; ++bj)
#pragma unroll
                    for (int n = 0; n < 2; ++n) *(GAS f32x4*)(xr + bj * HALF + n * 16) = xv[mm][bj][n] + gv[bj][n] * (acc[ai][bj][m0 + mm][n] + bv[bj][n]); }
            asm volatile("" ::: "memory"); }
    }
};
struct EpiResidN2 { static constexpr int BMAP = 1; static constexpr bool STAGGER = false; float* X; const float* modl; const float* norm2; bf16_t* A2; float* sumsq; const float* xp; const float* xs;
    __device__ __forceinline__ void operator()(f32x4 (&acc)[2][2][4][2], const Unit& u, int wr, int wc, int fr, int fq) const {
        const int col0 = u.pn * BM + wc * 32 + 8 * fq, rowt = u.pm * BM;
        const float* mp = modl + (size_t)mod_index(rowt) * 6 * D + col0;
        f32x4 gv[2][2], sv[2][2];
#pragma unroll
        for (int bj = 0; bj < 2; ++bj)
#pragma unroll
            for (int n = 0; n < 2; ++n) { gv[bj][n] = *(const GAS f32x4*)(mp + 2 * D + bj * HALF + 4 * n); sv[bj][n] = *(const GAS f32x4*)(norm2 + col0 + bj * HALF + 4 * n) * (*(const GAS f32x4*)(mp + 4 * D + bj * HALF + 4 * n) + 1.f); }
#pragma unroll
        for (int q = 0; q < 4; ++q) { const int ai = q >> 1, m0 = (q & 1) * 2; f32x4 xv[2][2][2];
#pragma unroll
            for (int mm = 0; mm < 2; ++mm) { const size_t ro = (size_t)(rowt + ai * HALF + wr * 64 + (m0 + mm) * 16 + fr) * D + col0; const float* xi = xp ? (rowt < MP ? xp + ro : xs + (ro - (size_t)MP * D)) : X + ro;
#pragma unroll
                for (int bj = 0; bj < 2; ++bj) { xv[mm][bj][0] = *(const GAS f32x4*)(xi + bj * HALF); xv[mm][bj][1] = *(const GAS f32x4*)(xi + bj * HALF + 4); } }
            float ssv[2];
#pragma unroll
            for (int mm = 0; mm < 2; ++mm) { const int m = m0 + mm; const size_t ro = (size_t)(rowt + ai * HALF + wr * 64 + m * 16 + fr) * D + col0; float ss = 0.f;
#pragma unroll
                for (int bj = 0; bj < 2; ++bj) { const f32x4 x0 = xv[mm][bj][0] + gv[bj][0] * acc[ai][bj][m][0], x1 = xv[mm][bj][1] + gv[bj][1] * acc[ai][bj][m][1];
                    *(GAS f32x4*)(X + ro + bj * HALF) = x0; *(GAS f32x4*)(X + ro + bj * HALF + 4) = x1;
                    ss += (x0[0] * x0[0] + x0[1] * x0[1]) + (x0[2] * x0[2] + x0[3] * x0[3]) + (x1[0] * x1[0] + x1[1] * x1[1]) + (x1[2] * x1[2] + x1[3] * x1[3]);
                    *(GAS u32x4*)(A2 + ro + bj * HALF) = pack8(x0 * sv[bj][0], x1 * sv[bj][1]); }
                { const int ln = fr + 16 * fq; ss += shx(ss, 16, ln); ss += shx(ss, 32, ln); } ssv[mm] = ss; }
            if (fq == 0) {
#pragma unroll
                for (int mm = 0; mm < 2; ++mm) (void)__hip_atomic_fetch_add((GAS float*)(sumsq + rowt + ai * HALF + wr * 64 + (m0 + mm) * 16 + fr), ssv[mm], __ATOMIC_RELAXED, __HIP_MEMORY_SCOPE_AGENT); }
            asm volatile("" ::: "memory"); }
    }
};
struct EpiMerge { static constexpr int BMAP = 1; static constexpr bool STAGGER = false; const bf16_t* GT; bf16_t* O;
    __device__ __forceinline__ void operator()(f32x4 (&acc)[2][2][4][2], const Unit& u, int wr, int wc, int fr, int fq) const {
        const int col0 = u.pn * BM + wc * 32 + 8 * fq; const size_t row0 = (size_t)(u.pm * BM + wr * 64 + fr);
        if (u.part == 0) {
#pragma unroll
            for (int ai = 0; ai < 2; ++ai)
#pragma unroll
                for (int m = 0; m < 4; ++m) { const bf16_t* g = GT + (row0 + ai * HALF + m * 16) * NG + col0;
#pragma unroll
                    for (int bj = 0; bj < 2; ++bj) { f32x4 a0, a1, d0, d1; unpack8(*(const GAS u32x4*)(g + bj * HALF), a0, a1); unpack8(*(const GAS u32x4*)(g + D + bj * HALF), d0, d1);
#pragma unroll
                        for (int j = 0; j < 4; ++j) { acc[ai][bj][m][0][j] *= a0[j] * __builtin_amdgcn_rcpf(d0[j]); acc[ai][bj][m][1][j] *= a1[j] * __builtin_amdgcn_rcpf(d1[j]); } }
                    if (m & 1) asm volatile("" ::: "memory"); }
        } else {
#pragma unroll
            for (int ai = 0; ai < 2; ++ai) { u32x4 gd[4][2];
#pragma unroll
                for (int m = 0; m < 4; ++m)
#pragma unroll
                    for (int bj = 0; bj < 2; ++bj) gd[m][bj] = *(const GAS u32x4*)(GT + (row0 + ai * HALF + m * 16) * NG + D + col0 + bj * HALF);
#pragma unroll
                for (int m = 0; m < 4; ++m) { bf16_t* o = O + (row0 + ai * HALF + m * 16) * D + col0;
#pragma unroll
                    for (int bj = 0; bj < 2; ++bj) { f32x4 d0, d1; unpack8(gd[m][bj], d0, d1); *(GAS u32x4*)(o + bj * HALF) = pack8(acc[ai][bj][m][0] * d0, acc[ai][bj][m][1] * d1); } }
                asm volatile("" ::: "memory"); }
        }
    }
};
struct EpiProjA { static constexpr int BMAP = 2; static constexpr bool STAGGER = true;
    int l; unsigned char* ws; float* out; const float* const* in;
    __device__ __forceinline__ void operator()(f32x4 (&acc)[2][2][4][2], const Unit& u, int wr, int wc, int fr, int fq) const {
        bf16_t* const QO = (bf16_t*)(ws + WS_QO); bf16_t* const KP = (bf16_t*)(ws + WS_KP); bf16_t* const VP = (bf16_t*)(ws + WS_VP); bf16_t* const KS = (bf16_t*)(ws + WS_KS); bf16_t* const VS = (bf16_t*)(ws + WS_VS);
        bf16_t* const CONV = (bf16_t*)(ws + WS_CONV); bf16_t* const GOUT = (bf16_t*)(ws + WS_GOUT); float* const LA = (float*)(ws + WS_LA); float* const BETA = (float*)(ws + WS_BETA);
        float* const nck = out + (size_t)M * D; float* const ncv = nck + (size_t)NPB * DEPTH * NKVH * TP * HD; const float* const rc = (const float*)(ws + WS_ROPE); const float* const rs = rc + TS * 32;
        const int pn = u.pn, rowt = u.pm * BM; const bool samp = rowt >= MP;
        const int b = samp ? (rowt - MP) / TS : rowt / TP, t0 = samp ? (rowt - MP) % TS : 0;
        const int rl0 = wr * 64 + fr;
        if (pn <= 2) {
            const bool is_q = pn < 2, is_v = (pn == 2 && wc >= 2); const int hh = is_q ? 4 * pn + wc : (wc & 1);
            f32x4 g[2][2];
            if (!is_v) { const float* gp = in[is_q ? 13 : 14] + l * 64 + 8 * fq;
#pragma unroll
                for (int bj = 0; bj < 2; ++bj)
#pragma unroll
                    for (int n = 0; n < 2; ++n) g[bj][n] = *(const GAS f32x4*)(gp + 32 * bj + 4 * n); }
#pragma unroll
            for (int ai = 0; ai < 2; ++ai)
#pragma unroll
                for (int m = 0; m < 4; ++m) { const int rl = rl0 + ai * HALF + m * 16, t = t0 + rl; const size_t row = (size_t)rowt + rl;
                    f32x4 x[2][2];
#pragma unroll
                    for (int bj = 0; bj < 2; ++bj)
#pragma unroll
                        for (int n = 0; n < 2; ++n) x[bj][n] = acc[ai][bj][m][n];
                    if (!is_v) { float ss = 0.f;
#pragma unroll
                        for (int bj = 0; bj < 2; ++bj)
#pragma unroll
                            for (int n = 0; n < 2; ++n) ss += (x[bj][n][0] * x[bj][n][0] + x[bj][n][1] * x[bj][n][1]) + (x[bj][n][2] * x[bj][n][2] + x[bj][n][3] * x[bj][n][3]);
                        { const int ln = fr + 16 * fq; ss += shx(ss, 16, ln); ss += shx(ss, 32, ln); }
                        const float rstd = __builtin_amdgcn_rsqf(ss * (1.f / 64.f) + EPS);
#pragma unroll
                        for (int bj = 0; bj < 2; ++bj)
#pragma unroll
                            for (int n = 0; n < 2; ++n) x[bj][n] = x[bj][n] * rstd * g[bj][n]; }
                    if (!samp && !is_q) { float* dst = (is_v ? ncv : nck) + ((((size_t)b * DEPTH + l) * NKVH + hh) * TP + t) * HD + 8 * fq;
#pragma unroll
                        for (int bj = 0; bj < 2; ++bj)
#pragma unroll
                            for (int n = 0; n < 2; ++n) *(GAS f32x4*)(dst + 32 * bj + 4 * n) = x[bj][n]; }
                    if (samp && !is_v) {
#pragma unroll
                        for (int n = 0; n < 2; ++n) { const f32x4 c = *(const GAS f32x4*)(rc + t * 32 + 8 * fq + 4 * n), s_ = *(const GAS f32x4*)(rs + t * 32 + 8 * fq + 4 * n);
                            const f32x4 x1 = x[0][n], x2 = x[1][n]; x[0][n] = x1 * c - x2 * s_; x[1][n] = x2 * c + x1 * s_; } }
                    bf16_t* dst;
                    if (is_q) { dst = QO + row * D + hh * 64;
#pragma unroll
                        for (int bj = 0; bj < 2; ++bj)
#pragma unroll
                            for (int n = 0; n < 2; ++n) x[bj][n] = x[bj][n] * C2; }
                    else if (!is_v) dst = samp ? KS + ((size_t)b * KEYS_S + PAST + t) * 128 + hh * 64 : KP + row * 128 + hh * 64;
                    else dst = samp ? VS + ((size_t)b * KEYS_S + PAST + t) * 128 + hh * 64 : VP + row * 128 + hh * 64;
#pragma unroll
                    for (int bj = 0; bj < 2; ++bj) *(GAS u32x4*)(dst + 32 * bj + 8 * fq) = pack8(x[bj][0], x[bj][1]);
                    asm volatile("" ::: "memory");
                }
        } else if (pn <= 8) {
            bf16_t* base = CONV + ((size_t)rowt + rl0) * CONVC + (pn - 3) * BM + wc * 64 + 8 * fq;
#pragma unroll
            for (int ai = 0; ai < 2; ++ai)
#pragma unroll
                for (int m = 0; m < 4; ++m)
#pragma unroll
                    for (int bj = 0; bj < 2; ++bj) { const u32x4 w = pack8(acc[ai][bj][m][0], acc[ai][bj][m][1]); *(GAS u32x4*)(base + (size_t)(ai * HALF + m * 16) * CONVC + 32 * bj) = w;
                        if ((m == 0 && fr == 0) || (m == 3 && fr == 15)) {
                            const int rl = rl0 + ai * HALF + m * 16, ck = (rowt + rl) >> 6;
                            *(GAS u32x4*)((bf16_t*)(ws + WS_BND) + ((size_t)ck * 2 + (m == 3 ? 1 : 0)) * CONVC + (pn - 3) * BM + wc * 64 + 8 * fq + 32 * bj) = w; } }
        } else if (pn <= 10) {
            bf16_t* base = GOUT + ((size_t)rowt + rl0) * 512 + (pn - 9) * BM + wc * 64 + 8 * fq;
#pragma unroll
            for (int ai = 0; ai < 2; ++ai)
#pragma unroll
                for (int m = 0; m < 4; ++m)
#pragma unroll
                    for (int bj = 0; bj < 2; ++bj) { const f32x4 a = acc[ai][bj][m][0], c = acc[ai][bj][m][1]; *(GAS u32x4*)(base + (size_t)(ai * HALF + m * 16) * 512 + 32 * bj) = pack8(a * fsig4(a), c * fsig4(c)); }
        } else if (wc == 0) {
            const int idx0 = 8 * (fq & 1); const bool isb = fq >= 2;
#pragma unroll
            for (int ai = 0; ai < 2; ++ai)
#pragma unroll
                for (int m = 0; m < 4; ++m) { const size_t row = (size_t)rowt + rl0 + ai * HALF + m * 16;
#pragma unroll
                    for (int n = 0; n < 2; ++n) { const f32x4 v = acc[ai][0][m][n]; f32x4 o;
                        if (isb) o = fsig4(v);
                        else {
#pragma unroll
                            for (int j = 0; j < 4; ++j) { const int idx = idx0 + 4 * n + j; const float xx = v[j] + ((const GAS float*)in[16])[l * 16 + idx]; const float y = __expf(xx); const float sp = xx > 20.f ? xx : (y < 0.01f ? y * (1.f - y * (0.5f - 0.33333333f * y)) : __logf(1.f + y)); o[j] = -__expf(((const GAS float*)in[15])[l * 16 + idx]) * sp; } }
                        *(GAS f32x4*)((isb ? BETA : LA) + row * 16 + idx0 + 4 * n) = o; } }
        }
    }
};

template <class Epi, class Sched, bool ALIGN_EPI = true, bool SP2 = true>
__device__ __forceinline__ void gemm_phase(PG8_LAS unsigned char* lds, const Shape g, const Sched& S, const Epi& E, const int tid_in) {
    int tid = tid_in; asm volatile("" : "+v"(tid));
    const int wid = __builtin_amdgcn_readfirstlane(tid >> 6), lane = tid & 63, wr = wid >> 2, wc = wid & 3, fr = lane & 15, fq = lane >> 4;
    const int nt = g.nt;
    unsigned voffA[2], voffB[2];
#pragma unroll
    for (int i = 0; i < 2; ++i) { int R, C; stage_rc(tid * 16 + i * 8192, R, C);
        const int Rb = Epi::BMAP == 0 ? R : Epi::BMAP == 1 ? ((R & ~31) + perm32(R & 31)) : ((R >> 5) * 64 + perm32(R & 31));
        voffA[i] = (unsigned)(R * g.lda + C) * 2u; voffB[i] = (unsigned)(Rb * g.ldb + C) * 2u; }
    const size_t kstep = (size_t)(BK * 2);
    const size_t hstepA = (size_t)HALF * g.lda * 2, hstepB = (size_t)(Epi::BMAP == 2 ? 32 : HALF) * g.ldb * 2;
    const unsigned ldsw = (unsigned)wid * 1024u;
    const int aoff = lds_byte(wr * 64 + fr, fq * 8), boff = lds_byte(wc * 32 + fr, fq * 8);
#define PG8_SA(b, h) (((b) * 2 + (h)) * HTB)
#define PG8_SB(b, h) ((4 + (b) * 2 + (h)) * HTB)
#define PG8_STAGE(bufoff, gbase, voff) do { _Pragma("unroll") for (int _i = 0; _i < 2; ++_i) \
        __builtin_amdgcn_global_load_lds((const GAS unsigned*)((const char*)(gbase) + (voff)[_i]), (PG8_LAS unsigned*)(lds + (bufoff) + ldsw + _i * 8192), 16, 0, 0); } while (0)
#define PG8_LDA(dst, b, h) do { _Pragma("unroll") for (int m = 0; m < 4; ++m) _Pragma("unroll") for (int k = 0; k < 2; ++k) dst[m][k] = *(const PG8_LAS bf16x8*)(lds + PG8_SA(b, h) + aoff + m * 2048 + k * 1024); } while (0)
#define PG8_LDB(dst, b, h) do { _Pragma("unroll") for (int n = 0; n < 2; ++n) _Pragma("unroll") for (int k = 0; k < 2; ++k) dst[n][k] = *(const PG8_LAS bf16x8*)(lds + PG8_SB(b, h) + boff + n * 2048 + k * 1024); } while (0)
#define PG8_MMA(ai, bj, At, Bt) do { __builtin_amdgcn_s_setprio(1); _Pragma("unroll") for (int m = 0; m < 4; ++m) _Pragma("unroll") for (int n = 0; n < 2; ++n) _Pragma("unroll") for (int k = 0; k < 2; ++k) \
        acc[ai][bj][m][n] = __builtin_amdgcn_mfma_f32_16x16x32_bf16(Bt[n][k], At[m][k], acc[ai][bj][m][n], 0, 0, 0); __builtin_amdgcn_s_setprio(0); } while (0)
#define PG8_WAIT_V(n) asm volatile("s_waitcnt vmcnt(" #n ")" ::: "memory")
#define PG8_WAIT_L(n) asm volatile("s_waitcnt lgkmcnt(" #n ")" ::: "memory")
#define PG8_BAR __builtin_amdgcn_s_barrier()
#define PG8_SCHED __builtin_amdgcn_sched_barrier(0)
    Unit cur, nxt; int ui = 0;
    if (!S.next(0, cur)) return;
    if (Epi::STAGGER && (blockIdx.x & 8)) __builtin_amdgcn_s_sleep(127);
    f32x4 acc[2][2][4][2];
#define PG8_ZERO() do { _Pragma("unroll") for (int a = 0; a < 2; ++a) _Pragma("unroll") for (int b = 0; b < 2; ++b) _Pragma("unroll") for (int m = 0; m < 4; ++m) _Pragma("unroll") for (int n = 0; n < 2; ++n) acc[a][b][m][n] = (f32x4){0.f, 0.f, 0.f, 0.f}; } while (0)
    PG8_ZERO();
    bf16x8 At[4][2], B0[2][2], B1[2][2];
    const char* cA = cur.a; const char* cB = cur.b;
    if constexpr (SP2) {
        PG8_STAGE(PG8_SB(0, 0), cB, voffB); PG8_STAGE(PG8_SB(0, 1), cB + hstepB, voffB); PG8_STAGE(PG8_SA(0, 0), cA, voffA); PG8_STAGE(PG8_SA(0, 1), cA + hstepA, voffA);
        if (wr == 1) PG8_BAR;
        PG8_WAIT_V(2); PG8_BAR;
        PG8_STAGE(PG8_SB(1, 0), cB + kstep, voffB); PG8_STAGE(PG8_SA(1, 0), cA + kstep, voffA); PG8_STAGE(PG8_SB(1, 1), cB + hstepB + kstep, voffB);
        PG8_WAIT_V(6); PG8_BAR;
    } else {
        PG8_STAGE(PG8_SB(0, 0), cB, voffB); PG8_STAGE(PG8_SA(0, 0), cA, voffA); PG8_STAGE(PG8_SB(0, 1), cB + hstepB, voffB); PG8_STAGE(PG8_SA(0, 1), cA + hstepA, voffA);
        if (wr == 1) PG8_BAR;
        PG8_WAIT_V(4); PG8_BAR;
        PG8_STAGE(PG8_SB(1, 0), cB + kstep, voffB); PG8_STAGE(PG8_SA(1, 0), cA + kstep, voffA); PG8_STAGE(PG8_SB(1, 1), cB + hstepB + kstep, voffB);
        PG8_WAIT_V(6); PG8_BAR;
    }
    for (;;) {
        const bool has_next = S.next(ui + 1, nxt);
        const char* nA = has_next ? nxt.a : cA; const char* nB = has_next ? nxt.b : cB;
        for (int t = 0; t < nt; t += 2) {
            const bool last = (t == nt - 2);
            const char* a1 = cA + (size_t)(t + 1) * kstep;
            const char* a2 = last ? nA : cA + (size_t)(t + 2) * kstep; const char* b2 = last ? nB : cB + (size_t)(t + 2) * kstep;
            const char* a3 = a2 + kstep; const char* b3 = b2 + kstep;
            if constexpr (SP2) {
            PG8_LDB(B0, 0, 0); PG8_LDB(B1, 0, 1); PG8_SCHED; PG8_LDA(At, 0, 0); PG8_STAGE(PG8_SA(1, 1), a1 + hstepA, voffA);
            PG8_WAIT_V(8); PG8_WAIT_L(0); PG8_BAR; PG8_MMA(0, 0, At, B0); PG8_MMA(0, 1, At, B1); PG8_BAR; PG8_SCHED;
            PG8_LDA(At, 0, 1); PG8_STAGE(PG8_SB(0, 0), b2, voffB); PG8_STAGE(PG8_SB(0, 1), b2 + hstepB, voffB); PG8_STAGE(PG8_SA(0, 0), a2, voffA);
            PG8_WAIT_V(8); PG8_WAIT_L(0); PG8_BAR; PG8_MMA(1, 0, At, B0); PG8_MMA(1, 1, At, B1); PG8_BAR; PG8_SCHED;
            PG8_LDB(B0, 1, 0); PG8_LDB(B1, 1, 1); PG8_SCHED; PG8_LDA(At, 1, 0); PG8_STAGE(PG8_SA(0, 1), a2 + hstepA, voffA);
            PG8_WAIT_V(8); PG8_WAIT_L(0); PG8_BAR; PG8_MMA(0, 0, At, B0); PG8_MMA(0, 1, At, B1); PG8_BAR; PG8_SCHED;
            PG8_LDA(At, 1, 1); PG8_STAGE(PG8_SB(1, 0), b3, voffB); PG8_STAGE(PG8_SB(1, 1), b3 + hstepB, voffB); PG8_STAGE(PG8_SA(1, 0), a3, voffA);
            PG8_WAIT_V(8); PG8_WAIT_L(0); PG8_BAR; PG8_MMA(1, 0, At, B0); PG8_MMA(1, 1, At, B1); PG8_BAR; PG8_SCHED;
            } else {
            PG8_LDB(B0, 0, 0); PG8_SCHED; PG8_LDA(At, 0, 0); PG8_STAGE(PG8_SA(1, 1), a1 + hstepA, voffA);
            PG8_WAIT_L(8); PG8_BAR; PG8_WAIT_L(0); PG8_MMA(0, 0, At, B0); PG8_BAR; PG8_SCHED;
            PG8_LDB(B1, 0, 1); PG8_STAGE(PG8_SB(0, 0), b2, voffB);
            PG8_BAR; PG8_WAIT_L(0); PG8_MMA(0, 1, At, B1); PG8_BAR;
            PG8_LDA(At, 0, 1); PG8_STAGE(PG8_SA(0, 0), a2, voffA);
            PG8_BAR; PG8_WAIT_L(0); PG8_MMA(1, 0, At, B0); PG8_BAR; PG8_SCHED;
            PG8_STAGE(PG8_SB(0, 1), b2 + hstepB, voffB);
            PG8_WAIT_V(6); PG8_BAR; PG8_MMA(1, 1, At, B1); PG8_BAR;
            PG8_LDB(B0, 1, 0); PG8_SCHED; PG8_LDA(At, 1, 0); PG8_STAGE(PG8_SA(0, 1), a2 + hstepA, voffA);
            PG8_WAIT_L(8); PG8_BAR; PG8_WAIT_L(0); PG8_MMA(0, 0, At, B0); PG8_BAR; PG8_SCHED;
            PG8_LDB(B1, 1, 1); PG8_STAGE(PG8_SB(1, 0), b3, voffB);
            PG8_BAR; PG8_WAIT_L(0); PG8_MMA(0, 1, At, B1); PG8_BAR;
            PG8_LDA(At, 1, 1); PG8_STAGE(PG8_SA(1, 0), a3, voffA);
            PG8_BAR; PG8_WAIT_L(0); PG8_MMA(1, 0, At, B0); PG8_BAR; PG8_SCHED;
            PG8_STAGE(PG8_SB(1, 1), b3 + hstepB, voffB);
            PG8_WAIT_V(6); PG8_BAR; PG8_MMA(1, 1, At, B1); PG8_BAR;
            }
        }
        if constexpr (ALIGN_EPI) { if (wr == 0) PG8_BAR; }
        { int fr_ = fr, fq_ = fq; asm volatile("" : "+v"(fr_), "+v"(fq_)); E(acc, cur, wr, wc, fr_, fq_); }
        if (!has_next) break;
        if (cur.part != 0) PG8_ZERO();
        cur = nxt; cA = nA; cB = nB; ++ui;
        if constexpr (ALIGN_EPI) { if (wr == 1) PG8_BAR; }
    }
    PG8_WAIT_V(0);
    if constexpr (!ALIGN_EPI) { if (wr == 0) PG8_BAR; }
    PG8_BAR;
#undef PG8_SA
#undef PG8_SB
#undef PG8_STAGE
#undef PG8_LDA
#undef PG8_LDB
#undef PG8_MMA
#undef PG8_WAIT_V
#undef PG8_WAIT_L
#undef PG8_BAR
#undef PG8_SCHED
#undef PG8_ZERO
}
}

__device__ __forceinline__ void ph_projA(Frame& F, int l) {
    pg8::TileOrder S; S.init(M / 256, NA_PAD / 256, F.G, F.bid, F.ws + WS_H, (size_t)256 * D * 2, F.ws + WS_W + W_INA, (size_t)256 * D * 2);
    pg8::EpiProjA E; E.l = l; E.ws = F.ws; E.out = F.out; E.in = F.in;
    pg8::gemm_phase<pg8::EpiProjA, pg8::TileOrder>(F.lds, pg8::Shape{D, D, D / 64}, S, E, F.tid);
}
__device__ __forceinline__ void ph_gates(Frame& F) {
    pg8::TileOrder S; S.init(M / 256, NG / 256, F.G, F.bid, F.ws + WS_H, (size_t)256 * D * 2, F.ws + WS_W + W_ING, (size_t)256 * D * 2);
    pg8::EpiGates E{(bf16*)(F.ws + WS_GATES)};
    pg8::gemm_phase<pg8::EpiGates, pg8::TileOrder>(F.lds, pg8::Shape{D, D, D / 64}, S, E, F.tid);
}
__device__ __forceinline__ void ph_merge(Frame& F) {
    pg8::TwoPartOrder S; S.init(M / 256, D / 256, F.G, F.bid, F.ws + WS_QO, (size_t)256 * D * 2, F.ws + WS_W + W_P, (size_t)256 * 512 * 2);
    S.B1 = (const char*)(F.ws + WS_W + W_P) + (size_t)D * 512 * 2; S.apart = 512 * 2;
    pg8::EpiMerge E{(const bf16*)(F.ws + WS_GATES), (bf16*)(F.ws + WS_H)};
    pg8::gemm_phase<pg8::EpiMerge, pg8::TwoPartOrder>(F.lds, pg8::Shape{D, 512, 512 / 64}, S, E, F.tid);
}
__device__ __forceinline__ void ph_resid_gemm(Frame& F, int l, const void* A, int K, const void* Bt, const float* bias, int gate_part, int row_lo, int nrows, bool from_inputs) {
    pg8::TileOrder S; S.init(nrows / 256, D / 256, F.G, F.bid, A, (size_t)256 * K * 2, Bt, (size_t)256 * K * 2);
    pg8::EpiResid E{F.out, bias, (const float*)(F.ws + WS_MOD) + (size_t)l * 5 * 6144, gate_part, row_lo, from_inputs ? F.in[0] : nullptr, from_inputs ? F.in[1] : nullptr};
    pg8::gemm_phase<pg8::EpiResid, pg8::TileOrder>(F.lds, pg8::Shape{K, K, K / 64}, S, E, F.tid);
}
__device__ __forceinline__ void ph_outproj(Frame& F, int l, bool from_inputs) {
    pg8::TileOrder S; S.init(M / 256, D / 256, F.G, F.bid, F.ws + WS_H, (size_t)256 * D * 2, F.ws + WS_W + W_OUT, (size_t)256 * D * 2);
    pg8::EpiResidN2 E{F.out, (const float*)(F.ws + WS_MOD) + (size_t)l * 5 * 6144, F.in[10] + l * D, (bf16*)(F.ws + WS_QO), (float*)(F.ws + WS_CTL + CTL_SUMSQ2) + (size_t)l * M, from_inputs ? F.in[0] : nullptr, from_inputs ? F.in[1] : nullptr};
    pg8::gemm_phase<pg8::EpiResidN2, pg8::TileOrder>(F.lds, pg8::Shape{D, D, D / 64}, S, E, F.tid);
}
__device__ __forceinline__ void ph_sb1(Frame& F) {
    LAS float* red = (LAS float*)F.lds;
    for (int it = F.bid; it < DEPTH * (FF / 64); it += F.G) { const int l = it / (FF / 64), n0 = (it % (FF / 64)) * 64;
        const float* w = F.in[21] + (size_t)l * D * FF + n0 + F.lane; const float* sh = (const float*)(F.ws + WS_MOD) + (size_t)l * 5 * 6144 + 3 * D;
        float acc[5] = {0.f, 0.f, 0.f, 0.f, 0.f};
        for (int k = F.wave * 128; k < F.wave * 128 + 128; ++k) { const float wv = *(const GAS float*)(w + (size_t)k * FF);
#pragma unroll
            for (int j = 0; j < 5; ++j) acc[j] += *(const GAS float*)(sh + (size_t)j * 6144 + k) * wv; }
#pragma unroll
        for (int j = 0; j < 5; ++j) red[(F.wave * 5 + j) * 64 + F.lane] = acc[j];
        __syncthreads();
        if (F.tid < 320) { const int j = F.tid / 64, n = F.tid % 64; float sum = F.in[22][l * FF + n0 + n];
            for (int w8 = 0; w8 < 8; ++w8) sum += red[(w8 * 5 + j) * 64 + n];
            ((float*)(F.ws + WS_SB1))[((size_t)l * 5 + j) * FF + n0 + n] = sum; }
        __syncthreads(); }
}
__device__ __forceinline__ void ffn1_units(Frame& F, int l, int row_lo, int nrt, bf16* out, int nw, int c) {
    pg8::TileOrder S; S.init(nrt, FF / 256, nw, c, F.ws + WS_QO + (size_t)row_lo * D * 2, (size_t)256 * D * 2, F.ws + WS_W + W_1, (size_t)256 * D * 2);
    pg8::EpiFfn1 E{out, (const float*)(F.ws + WS_SB1) + (size_t)l * 5 * FF, (const float*)(F.ws + WS_CTL + CTL_SUMSQ2) + (size_t)l * M, row_lo};
    pg8::gemm_phase<pg8::EpiFfn1, pg8::TileOrder>(F.lds, pg8::Shape{D, D, D / 64}, S, E, F.tid);
}
__device__ __forceinline__ void ph_ffn2(Frame& F, int l, int row_off, int split) {
    pg8::SplitAOrder S; S.init((M / 2) / 256, D / 256, F.G, F.bid, F.ws + WS_FF, (size_t)256 * FF * 2, F.ws + WS_W + W_2, (size_t)256 * FF * 2); S.A_lo = (const char*)(F.ws + WS_H); S.split = split;
    pg8::EpiResid E{F.out, F.in[24] + l * D, (const float*)(F.ws + WS_MOD) + (size_t)l * 5 * 6144, 5, row_off, nullptr, nullptr};
    pg8::gemm_phase<pg8::EpiResid, pg8::SplitAOrder>(F.lds, pg8::Shape{FF, FF, FF / 64}, S, E, F.tid);
}

#include <hip/hip_bf16.h>
#include <cmath>
namespace attn_body {
using bf16=__hip_bfloat16;
using bf16x8=__attribute__((ext_vector_type(8)))short;
using s16x4=__attribute__((ext_vector_type(4)))short;
using f32x16=__attribute__((ext_vector_type(16)))float;
using u32x4=__attribute__((ext_vector_type(4)))unsigned;
constexpr int D=64,DM=1024,KVP=128;
constexpr int NW=8,QBLK=32,QB=QBLK*NW,KVBLK=64;
constexpr int ATTN_PITCH=DM, ATTN_UNIT_ROWS=QB;
__device__ __forceinline__ int crow(int r,int hi){return (r&3)+8*(r>>2)+4*hi;}
#define SBAR() __builtin_amdgcn_sched_barrier(0)
__device__ __forceinline__ void cmask(f32x16&p0,f32x16&p1,int jb,int qrel,int hi){
  const float NEG=-INFINITY; int kb=64*jb+4*hi;
  #pragma unroll
  for(int r=0;r<16;++r){int kv=kb+(r&3)+8*(r>>2); if(kv>qrel)p0[r]=NEG; if(kv+32>qrel)p1[r]=NEG;}
}

constexpr int NSLOT=3, SLOTB=8192;
constexpr int LDS_K=0, LDS_V=NSLOT*SLOTB, LDS_WS=2*NSLOT*SLOTB, LDS_OST=LDS_WS+NW*64*4, LDS_BYTES=LDS_OST+NW*4096;
constexpr float C2=0.125f*1.4426950408889634f;
__device__ __forceinline__ void glds16(const void*gsrc,unsigned lds_dst){unsigned keep;
  asm volatile("s_mov_b32 %0, m0\n\ts_mov_b32 m0, %2\n\ts_nop 0\n\tglobal_load_lds_dwordx4 %1, off\n\ts_mov_b32 m0, %0":"=&s"(keep):"v"(gsrc),"s"(lds_dst):"memory");}
__device__ __forceinline__ float max3f(float a,float b,float c){float r;asm("v_max3_f32 %0, %1, %2, %3":"=v"(r):"v"(a),"v"(b),"v"(c));return r;}
__device__ __forceinline__ float max2f(float a,float b){float r;asm("v_max_f32_e32 %0, %1, %2":"=v"(r):"v"(a),"v"(b));return r;}
__device__ __forceinline__ float fadd_s(float a,float b){float r;asm("v_add_f32_e32 %0, %1, %2":"=v"(r):"v"(a),"v"(b));return r;}
__device__ __forceinline__ float fsub_s(float a,float b){float r;asm("v_sub_f32_e32 %0, %1, %2":"=v"(r):"v"(a),"v"(b));return r;}
typedef float f32x2_t __attribute__((ext_vector_type(2))); typedef __bf16 bf16x2_t __attribute__((ext_vector_type(2)));
__device__ __forceinline__ unsigned cvtpk_s(float lo,float hi){f32x2_t v={lo,hi};bf16x2_t b=__builtin_convertvector(v,bf16x2_t);return __builtin_bit_cast(unsigned,b);}
#define WAIT_BAR(N) asm volatile("s_waitcnt vmcnt(" #N ") lgkmcnt(0)\n\ts_barrier":::"memory")

__device__ __forceinline__ void qkt(f32x16&p0,f32x16&p1,const char*Kslot,const bf16x8*qr,const f32x16&negm,int r32,int hi){
  const char*kb=Kslot+hi*1024+r32*16;
  #pragma unroll
  for(int d0=0;d0<4;++d0){
    const bf16x8 b0=*reinterpret_cast<const bf16x8*>(kb+d0*2048);
    const bf16x8 b1=*reinterpret_cast<const bf16x8*>(kb+d0*2048+512);
    if(d0==0){p0=__builtin_amdgcn_mfma_f32_32x32x16_bf16(b0,qr[0],negm,0,0,0);p1=__builtin_amdgcn_mfma_f32_32x32x16_bf16(b1,qr[0],negm,0,0,0);}
    else{p0=__builtin_amdgcn_mfma_f32_32x32x16_bf16(b0,qr[d0],p0,0,0,0);p1=__builtin_amdgcn_mfma_f32_32x32x16_bf16(b1,qr[d0],p1,0,0,0);}}
}
typedef __attribute__((address_space(3))) const char* lds_cptr;
typedef short v4i16_t __attribute__((ext_vector_type(4)));
__device__ __forceinline__ void kload8(bf16x8*kf,lds_cptr kp){
  kf[0]=*(const __attribute__((address_space(3))) bf16x8*)(kp);      kf[1]=*(const __attribute__((address_space(3))) bf16x8*)(kp+512);
  kf[2]=*(const __attribute__((address_space(3))) bf16x8*)(kp+2048); kf[3]=*(const __attribute__((address_space(3))) bf16x8*)(kp+2560);
  kf[4]=*(const __attribute__((address_space(3))) bf16x8*)(kp+4096); kf[5]=*(const __attribute__((address_space(3))) bf16x8*)(kp+4608);
  kf[6]=*(const __attribute__((address_space(3))) bf16x8*)(kp+6144); kf[7]=*(const __attribute__((address_space(3))) bf16x8*)(kp+6656);
}
__device__ __forceinline__ void kload2(bf16x8*kf,lds_cptr kp,int j){ kf[2*j]=*(const __attribute__((address_space(3))) bf16x8*)(kp+j*2048); kf[2*j+1]=*(const __attribute__((address_space(3))) bf16x8*)(kp+j*2048+512); }
__device__ __forceinline__ s16x4 vtr(lds_cptr p){ return __builtin_bit_cast(s16x4,__builtin_amdgcn_ds_read_tr16_b64_v4i16((__attribute__((address_space(3))) v4i16_t*)p)); }
__device__ __forceinline__ float rowmax(const f32x16&p0,const f32x16&p1){
  float a=max3f(p0[0],p0[1],p1[0]),b=max3f(p0[2],p0[3],p1[1]);a=max3f(a,p1[2],p1[3]);
  #pragma unroll
  for(int r=4;r<16;r+=4){a=max3f(a,p0[r],p0[r+1]);b=max3f(b,p0[r+2],p0[r+3]);a=max3f(a,p1[r],p1[r+1]);b=max3f(b,p1[r+2],p1[r+3]);}
  const float m=max2f(a,b);
  auto rr=__builtin_amdgcn_permlane32_swap(__float_as_uint(m),__float_as_uint(m),false,false);
  return max2f(__uint_as_float(rr[0]),__uint_as_float(rr[1]));
}
__device__ __forceinline__ void pv(f32x16*o,int vb,bf16x8 pa0,bf16x8 pa1,bf16x8 pa2,bf16x8 pa3){
  #pragma unroll
  for(int d0=0;d0<2;++d0){s16x4 lo[4],hi[4];
    #pragma unroll
    for(int ks=0;ks<4;++ks){
      asm volatile("ds_read_b64_tr_b16 %0,%1 offset:%c2":"=&v"(lo[ks]):"v"(vb),"i"(d0*4096+ks*1024):"memory");
      asm volatile("ds_read_b64_tr_b16 %0,%1 offset:%c2":"=&v"(hi[ks]):"v"(vb),"i"(d0*4096+ks*1024+512):"memory");}
    asm volatile("s_waitcnt lgkmcnt(0)":::"memory");SBAR();
    #define PK(k) (bf16x8){lo[k][0],lo[k][1],lo[k][2],lo[k][3],hi[k][0],hi[k][1],hi[k][2],hi[k][3]}
    o[d0]=__builtin_amdgcn_mfma_f32_32x32x16_bf16(pa0,PK(0),o[d0],0,0,0);
    o[d0]=__builtin_amdgcn_mfma_f32_32x32x16_bf16(pa1,PK(1),o[d0],0,0,0);
    o[d0]=__builtin_amdgcn_mfma_f32_32x32x16_bf16(pa2,PK(2),o[d0],0,0,0);
    o[d0]=__builtin_amdgcn_mfma_f32_32x32x16_bf16(pa3,PK(3),o[d0],0,0,0);
    #undef PK
  }
}

#ifndef ATTN_STORE16
#define ATTN_STORE16(p,v) (*(__attribute__((address_space(1))) u32x4*)(p)=(v))
#endif
template<int THRL> __device__ __forceinline__ void attn_unit(bf16*Qu,const bf16*__restrict__ Kh,const bf16*__restrict__ Vh,const int NT,char*shm,const int tid_in){
  int tid=tid_in; asm volatile("":"+v"(tid));
  const int lane=tid&63,r32=lane&31,hi=lane>>5; const int wid=__builtin_amdgcn_readfirstlane(tid>>6);
  const bf16*Qw=Qu+(long)(wid*QBLK)*DM;
  const unsigned lds0=(unsigned)(uintptr_t)shm;
  float*wsf=(float*)(shm+LDS_WS)+wid*64;
  const bf16*ksrc=Kh+(long)lane*KVP+wid*8;
  const bf16*vsrc=Vh+(long)(16*(wid&3)+(lane>>2))*KVP+(wid>>2)*32+(lane&3)*8;
  const unsigned kdst=lds0+LDS_K+wid*1024, vdst=lds0+LDS_V+wid*1024;
  #define DMA_K(t,slot) glds16(ksrc+(long)(t)*KVBLK*KVP,(unsigned)__builtin_amdgcn_readfirstlane(kdst+(slot)))
  #define DMA_V(t,slot) glds16(vsrc+(long)(t)*KVBLK*KVP,(unsigned)__builtin_amdgcn_readfirstlane(vdst+(slot)))
  const int vb0=(int)(lds0+LDS_V)+((lane>>4)&1)*32+(lane&3)*8+(4*hi+((lane&15)>>2))*64;
  const char*Kbase=shm+LDS_K; bf16x8 kf[8];
  const lds_cptr shm3=(lds_cptr)shm; const lds_cptr kp0=shm3+LDS_K+hi*1024+r32*16; const lds_cptr vp0=shm3+LDS_V+((lane>>4)&1)*32+(lane&3)*8+(4*hi+((lane&15)>>2))*64;
  DMA_K(0,0);DMA_V(0,0);DMA_K(1,SLOTB);
  bf16x8 qr[4];
  #pragma unroll
  for(int d0=0;d0<4;++d0)qr[d0]=*(const __attribute__((address_space(1))) bf16x8*)(&Qw[(long)r32*DM+d0*16+hi*8]);
  float mhat=0.f,l_reg=0.f;f32x16 o[2];o[0]=f32x16{};o[1]=f32x16{};f32x16 negm=f32x16{};asm volatile("":"+v"(negm));
  #define CMASK(P0,P1,t) do{}while(0)
  bool resc=false;
  #define START(P0,P1) do{ const float rm=rowmax(P0,P1); resc=false; \
    { const float dl=rm; mhat=fadd_s(mhat,dl); \
      _Pragma("unroll") for(int r=0;r<16;++r){P0[r]=fsub_s(P0[r],dl);P1[r]=fsub_s(P1[r],dl);} \
      _Pragma("unroll") for(int r=0;r<16;++r)negm[r]=-mhat; asm volatile("":"+v"(negm)); } \
    _Pragma("unroll") for(int r=0;r<16;++r)P0[r]=__builtin_amdgcn_exp2f(P0[r]); }while(0)
  #define RESC() do{ if(resc){ asm volatile("s_waitcnt lgkmcnt(0)":::"memory"); \
      _Pragma("unroll") for(int d_=0;d_<2;++d_) _Pragma("unroll") for(int r=0;r<16;++r)o[d_][r]*=wsf[crow(r,hi)]; } }while(0)
  f32x16 pA0,pA1,pB0,pB1;
  int sl_prev=0,sl_cur=0,sl_next=SLOTB;
  #define ROT() do{sl_prev=sl_cur;sl_cur=sl_next;sl_next=(sl_next==(NSLOT-1)*SLOTB)?0:sl_next+SLOTB;}while(0)
  DMA_K(2,2*SLOTB);
  WAIT_BAR(3);
  qkt(pA0,pA1,Kbase,qr,negm,r32,hi);asm volatile("s_nop 15\n\ts_nop 7":"+v"(pA0),"+v"(pA1));CMASK(pA0,pA1,0);
  START(pA0,pA1);
  _Pragma("unroll") for(int r=0;r<16;++r)pA1[r]=__builtin_amdgcn_exp2f(pA1[r]);
  WAIT_BAR(0);
  DMA_K(3,0);DMA_V(1,SLOTB);
  ROT();
  kload8(kf,kp0+sl_cur);
  WAIT_BAR(2);
  s16x4 vlo[8],vhi[8]; u32x4 pw0,pw1,pw2,pw3;
  #define PKW(P,B) cvtpk_s(P[B],P[B+1])
  #define PAF(k) __builtin_bit_cast(bf16x8,pw##k)
  #define VFR(i) (bf16x8){vlo[i][0],vlo[i][1],vlo[i][2],vlo[i][3],vhi[i][0],vhi[i][1],vhi[i][2],vhi[i][3]}
  #define PIN(x) asm volatile("":"+v"(x))
  #define MX3(a,b,c) __builtin_fmaxf(__builtin_fmaxf((a),(b)),(c))
  #define GAPA(MF,A0,A1,A2,A3,W0,W1,PW) do{ MF; sacc+=A0; sacc+=A1; sacc+=A2; sacc+=A3; PIN(sacc); W0; W1; PIN(PW); SBAR(); }while(0)
  #define EX(v) __builtin_amdgcn_exp2f(v)
  #define GAPB(MF,X,B) do{ MF; X[B]=EX(X[B]); X[B+1]=EX(X[B+1]); X[B+2]=EX(X[B+2]); X[B+3]=EX(X[B+3]); PIN(X); SBAR(); }while(0)
  #define VRD(i) do{ vlo[i]=vtr(vp_+(((i)>>2)*4096+((i)&3)*1024)); vhi[i]=vtr(vp_+(((i)>>2)*4096+((i)&3)*1024+512)); }while(0)
  #define KRD(G,j) do{ if(G){ kload2(kf,kp0+sl_next,j); SBAR(); } }while(0)
  #define STEP(C0,C1,P0,P1,t,GK,GV,GL) do{ SBAR(); \
    const lds_cptr vp_=vp0+sl_prev; \
    VRD(0); SBAR(); float sacc=(P0[0]+P0[1]); \
    GAPA(C0=__builtin_amdgcn_mfma_f32_32x32x16_bf16(kf[0],qr[0],negm,0,0,0), P0[2],P0[3],P0[4],P0[5],     pw0[0]=PKW(P0,0), pw0[1]=PKW(P0,2), pw0); \
    VRD(4); SBAR(); GAPA(C1=__builtin_amdgcn_mfma_f32_32x32x16_bf16(kf[1],qr[0],negm,0,0,0), P0[6],P0[7],P0[8],P0[9],     pw0[2]=PKW(P0,4), pw0[3]=PKW(P0,6), pw0); \
    VRD(1); SBAR(); GAPA(C0=__builtin_amdgcn_mfma_f32_32x32x16_bf16(kf[2],qr[1],C0,0,0,0),   P0[10],P0[11],P0[12],P0[13], pw1[0]=PKW(P0,8), pw1[1]=PKW(P0,10), pw1); \
    VRD(5); SBAR(); GAPA(C1=__builtin_amdgcn_mfma_f32_32x32x16_bf16(kf[3],qr[1],C1,0,0,0),   P0[14],P0[15],P1[0],P1[1],   pw1[2]=PKW(P0,12),pw1[3]=PKW(P0,14), pw1); \
    VRD(2); SBAR(); GAPA(C0=__builtin_amdgcn_mfma_f32_32x32x16_bf16(kf[4],qr[2],C0,0,0,0),   P1[2],P1[3],P1[4],P1[5],     pw2[0]=PKW(P1,0), pw2[1]=PKW(P1,2), pw2); \
    VRD(6); SBAR(); GAPA(C1=__builtin_amdgcn_mfma_f32_32x32x16_bf16(kf[5],qr[2],C1,0,0,0),   P1[6],P1[7],P1[8],P1[9],     pw2[2]=PKW(P1,4), pw2[3]=PKW(P1,6), pw2); \
    VRD(3); SBAR(); GAPA(C0=__builtin_amdgcn_mfma_f32_32x32x16_bf16(kf[6],qr[3],C0,0,0,0),   P1[10],P1[11],P1[12],P1[13], pw3[0]=PKW(P1,8), pw3[1]=PKW(P1,10), pw3); \
    VRD(7); SBAR(); GAPA(C1=__builtin_amdgcn_mfma_f32_32x32x16_bf16(kf[7],qr[3],C1,0,0,0),   P1[14],P1[15],0.f,0.f,       pw3[2]=PKW(P1,12),pw3[3]=PKW(P1,14), pw3); \
    l_reg+=sacc; \
    if(GK){DMA_K((t)+3,sl_cur);} if(GV){DMA_V((t)+1,sl_next);} \
    CMASK(C0,C1,t); \
    { float a=MX3(C0[0],C0[1],C1[0]),b=MX3(C0[2],C0[3],C1[1]); a=MX3(a,C1[2],C1[3]); \
      _Pragma("unroll") for(int r=4;r<16;r+=4){a=MX3(a,C0[r],C0[r+1]);b=MX3(b,C0[r+2],C0[r+3]);a=MX3(a,C1[r],C1[r+1]);b=MX3(b,C1[r+2],C1[r+3]);} \
      float rm=__builtin_fmaxf(a,b); { auto rr=__builtin_amdgcn_permlane32_swap(__float_as_uint(rm),__float_as_uint(rm),false,false); rm=__builtin_fmaxf(__uint_as_float(rr[0]),__uint_as_float(rr[1])); } \
      resc=false; \
      if(__builtin_expect(__any(rm>(float)THRL),0)){ const float dl=__builtin_fmaxf(rm,0.f); mhat+=dl; \
        _Pragma("unroll") for(int r=0;r<16;++r){C0[r]-=dl;C1[r]-=dl;} \
        _Pragma("unroll") for(int r=0;r<16;++r)negm[r]=-mhat; asm volatile("":"+v"(negm)); \
        const float f=__builtin_amdgcn_exp2f(-dl); l_reg*=f; if(hi==0)wsf[r32]=f; resc=true; } } \
    SBAR(); \
    GAPB(o[0]=__builtin_amdgcn_mfma_f32_32x32x16_bf16(PAF(0),VFR(0),o[0],0,0,0), C0,0); \
    GAPB(o[1]=__builtin_amdgcn_mfma_f32_32x32x16_bf16(PAF(0),VFR(4),o[1],0,0,0), C0,4); \
    KRD(GL,0); GAPB(o[0]=__builtin_amdgcn_mfma_f32_32x32x16_bf16(PAF(1),VFR(1),o[0],0,0,0), C0,8); \
    KRD(GL,1); GAPB(o[1]=__builtin_amdgcn_mfma_f32_32x32x16_bf16(PAF(1),VFR(5),o[1],0,0,0), C0,12); \
    KRD(GL,2); GAPB(o[0]=__builtin_amdgcn_mfma_f32_32x32x16_bf16(PAF(2),VFR(2),o[0],0,0,0), C1,0); \
    KRD(GL,3); GAPB(o[1]=__builtin_amdgcn_mfma_f32_32x32x16_bf16(PAF(2),VFR(6),o[1],0,0,0), C1,4); \
    GAPB(o[0]=__builtin_amdgcn_mfma_f32_32x32x16_bf16(PAF(3),VFR(3),o[0],0,0,0), C1,8); \
    GAPB(o[1]=__builtin_amdgcn_mfma_f32_32x32x16_bf16(PAF(3),VFR(7),o[1],0,0,0), C1,12); \
    }while(0)
  int t=1;
  #undef CMASK
  #define CMASK(P0,P1,t) do{}while(0)
  for(;t+5<NT;t+=2){
    STEP(pB0,pB1,pA0,pA1,t,true,true,true);     WAIT_BAR(2); RESC(); ROT();
    STEP(pA0,pA1,pB0,pB1,t+1,true,true,true);   WAIT_BAR(2); RESC(); ROT();
  }
  #undef CMASK
  #define CMASK(P0,P1,t) do{}while(0)
  #define ENDW(tt) do{ if((tt)+3<NT){WAIT_BAR(2);} else if((tt)+2<NT){WAIT_BAR(1);} else {WAIT_BAR(0);} }while(0)
  for(;t+1<NT;t+=2){
    STEP(pB0,pB1,pA0,pA1,t,(t+3<NT),(t+1<NT),(t+1<NT));       ENDW(t);   RESC(); ROT();
    STEP(pA0,pA1,pB0,pB1,t+1,(t+4<NT),(t+2<NT),(t+2<NT));     ENDW(t+1); RESC(); ROT();
  }
  STEP(pB0,pB1,pA0,pA1,NT-1,false,false,false); RESC();
  { float sacc=pB0[0]+pB0[1]; _Pragma("unroll") for(int r=2;r<16;++r)sacc+=pB0[r]; _Pragma("unroll") for(int r=0;r<16;++r)sacc+=pB1[r]; l_reg+=sacc;
    pw0=(u32x4){PKW(pB0,0),PKW(pB0,2),PKW(pB0,4),PKW(pB0,6)};pw1=(u32x4){PKW(pB0,8),PKW(pB0,10),PKW(pB0,12),PKW(pB0,14)};pw2=(u32x4){PKW(pB1,0),PKW(pB1,2),PKW(pB1,4),PKW(pB1,6)};pw3=(u32x4){PKW(pB1,8),PKW(pB1,10),PKW(pB1,12),PKW(pB1,14)};
    SBAR(); pv(o,vb0+sl_cur,PAF(0),PAF(1),PAF(2),PAF(3)); }
  #undef PKW
  #undef PAF
  #undef VFR
  #undef PIN
  #undef MX3
  #undef GAPA
  #undef GAPB
  #undef EX
  #undef VRD
  #undef KRD
  #undef STEP
  #undef ENDW
  {auto rr=__builtin_amdgcn_permlane32_swap(__float_as_uint(l_reg),__float_as_uint(l_reg),false,false);l_reg=__uint_as_float(rr[0])+__uint_as_float(rr[1]);}
  if(hi==0)wsf[32+r32]=l_reg;asm volatile("s_waitcnt lgkmcnt(0)":::"memory");
  float rli[16];
  #pragma unroll
  for(int r=0;r<16;++r)rli[r]=__builtin_amdgcn_rcpf(wsf[32+crow(r,hi)]);
  bf16*Ow=Qu+(long)(wid*QBLK)*DM;
  { bf16*stg=(bf16*)(shm+LDS_OST)+wid*2048;
    #pragma unroll
    for(int r=0;r<16;++r){const int orow=crow(r,hi);
      #pragma unroll
      for(int d0=0;d0<2;++d0)stg[orow*64+d0*32+r32]=__float2bfloat16(o[d0][r]*rli[r]);}
    asm volatile("s_waitcnt lgkmcnt(0)":::"memory");
    #pragma unroll
    for(int i=0;i<4;++i){const int row=i*8+(lane>>3),ch=lane&7; const u32x4 v=*(const u32x4*)(stg+row*64+ch*8); ATTN_STORE16(Ow+(long)row*DM+ch*8,v);} }
  asm volatile("s_waitcnt lgkmcnt(0)\n\ts_barrier":::"memory");
  #undef DMA_K
  #undef DMA_V
  #undef CMASK
  #undef START
  #undef RESC
  #undef ROT
}
constexpr int ATTN_LDS_BYTES=LDS_BYTES;
#undef SBAR
#undef WAIT_BAR
}

__device__ __forceinline__ void attn_units(Frame& F, char* lds_generic) {
    typedef attn_body::bf16 abf;
    const bool bal = F.G == 256; const int jj = (F.bid >> 3) - 8, x = F.bid & 7;
    if (F.bid >= 64) {
        const int W = F.G - 64, j = F.bid - 64; const bool xaff = (F.G & 7) == 0; const int nper = W >> 3;
        for (int i = 0;; ++i) {
            int b, h, qb;
            if (xaff) { const int r = jj + i * nper; if (r >= 64) break; b = x >> 1; h = 4 * (x & 1) + (r & 3); qb = r >> 2; }
            else { const int idx = j + i * W; if (idx >= 512) break; const int xx = idx & 7, r = idx >> 3; b = xx >> 1; h = 4 * (xx & 1) + (r & 3); qb = r >> 2; }
            const int kvh = h >> 2;
            abf* Qu = (abf*)(F.ws + WS_QO) + (size_t)(MP + b * TS + qb * 256) * D + h * 64;
            const abf* Kh = (const abf*)(F.ws + WS_KS) + (size_t)b * KEYS_S * 128 + kvh * 64; const abf* Vh = (const abf*)(F.ws + WS_VS) + (size_t)b * KEYS_S * 128 + kvh * 64;
            attn_body::attn_unit<8>(Qu, Kh, Vh, KEYS_S / 64, lds_generic, F.tid);
        }
    }
    int i0, istep, icnt;
    if (bal) { if (F.bid < 64) { i0 = 2 * F.bid; istep = 1; icnt = 2; } else if (jj >= 16) { i0 = 128 + 2 * (x * 8 + (jj - 16)); istep = 1; icnt = 2; } else { i0 = 0; istep = 1; icnt = 0; } }
    else { if (F.bid < 64) { i0 = 0; istep = 1; icnt = 0; } else { i0 = F.bid - 64; istep = F.G - 64; icnt = (NPB * NQH - i0 + istep - 1) / istep; } }
    for (int k = 0; k < icnt; ++k) { const int idx = i0 + k * istep; if (idx >= NPB * NQH) break;
        const int b = idx >> 3, h = idx & 7, kvh = h >> 2;
        abf* Qu = (abf*)(F.ws + WS_QO) + (size_t)(b * TP) * D + h * 64;
        const abf* Kh = (const abf*)(F.ws + WS_KP) + (size_t)b * TP * 128 + kvh * 64; const abf* Vh = (const abf*)(F.ws + WS_VP) + (size_t)b * TP * 128 + kvh * 64;
        attn_body::attn_unit<8>(Qu, Kh, Vh, TP / 64, lds_generic, F.tid);
    }
}

__device__ __forceinline__ void ph_delta_pre(Frame& F, int l) {
    bf16* CONV = (bf16*)(F.ws + WS_CONV); const bf16* BND = (const bf16*)(F.ws + WS_BND); float* LA = (float*)(F.ws + WS_LA); const float* BETA = (const float*)(F.ws + WS_BETA); bf16* TP = (bf16*)(F.ws + WS_H);
    const float* cw = F.in[12] + (size_t)l * 3 * CONVC;
    LAS unsigned char* Kl = F.lds;
    LAS float* KK = (LAS float*)(F.lds + 36864);
    LAS float* GB = (LAS float*)(F.lds + 36864 + 69632) + F.wave * 128;
    const int r = F.tid >> 3, cb = (F.tid & 7) * 8, lane = F.lane, q4 = lane >> 4, l15 = lane & 15;
    const int hh = F.wave >> 1, dirw = F.wave & 1;
    for (int it = F.bid; it < (M / 64) * 2; it += F.G) {
        const int ck = it >> 1, hq = it & 1; const int cs = ck < MP / 64 ? (ck & 3) : ((ck - MP / 64) & 63), ncs = ck < MP / 64 ? 4 : 64;
        const size_t tok = (size_t)ck * 64 + r;
        for (int h4 = 0; h4 < 4; ++h4) { const int h = 4 * hq + h4;
            float y[3][8];
#pragma unroll
            for (int s3 = 0; s3 < 3; ++s3) { const int col = s3 * 512 + h * 64 + cb;
                const v4u x0 = *(const GAS v4u*)(CONV + tok * CONVC + col);
                v4u xm = (v4u){0u, 0u, 0u, 0u}, xp = (v4u){0u, 0u, 0u, 0u};
                if (r > 0) xm = *(const GAS v4u*)(CONV + (tok - 1) * CONVC + col); else if (cs > 0) xm = *(const GAS v4u*)(BND + ((size_t)(ck - 1) * 2 + 1) * CONVC + col);
                if (r < 63) xp = *(const GAS v4u*)(CONV + (tok + 1) * CONVC + col); else if (cs < ncs - 1) xp = *(const GAS v4u*)(BND + ((size_t)(ck + 1) * 2) * CONVC + col);
                const f32x4 w0a = *(const GAS f32x4*)(cw + col), w0b = *(const GAS f32x4*)(cw + col + 4), w1a = *(const GAS f32x4*)(cw + CONVC + col), w1b = *(const GAS f32x4*)(cw + CONVC + col + 4),
                            w2a = *(const GAS f32x4*)(cw + 2 * CONVC + col), w2b = *(const GAS f32x4*)(cw + 2 * CONVC + col + 4);
                const float w0[8] = {w0a[0], w0a[1], w0a[2], w0a[3], w0b[0], w0b[1], w0b[2], w0b[3]}, w1[8] = {w1a[0], w1a[1], w1a[2], w1a[3], w1b[0], w1b[1], w1b[2], w1b[3]}, w2[8] = {w2a[0], w2a[1], w2a[2], w2a[3], w2b[0], w2b[1], w2b[2], w2b[3]};
                const unsigned xmw[4] = {xm.x, xm.y, xm.z, xm.w}, x0w[4] = {x0.x, x0.y, x0.z, x0.w}, xpw[4] = {xp.x, xp.y, xp.z, xp.w};
#pragma unroll
                for (int i = 0; i < 8; ++i) { const float a = (i & 1) ? bfhi(xmw[i >> 1]) : bflo(xmw[i >> 1]), b = (i & 1) ? bfhi(x0w[i >> 1]) : bflo(x0w[i >> 1]), c = (i & 1) ? bfhi(xpw[i >> 1]) : bflo(xpw[i >> 1]);
                    y[s3][i] = siluf_(a * w0[i] + b * w1[i] + c * w2[i]); }
                if (s3 < 2) { float ss = 0.f;
#pragma unroll
                    for (int i = 0; i < 8; ++i) ss += y[s3][i] * y[s3][i];
                    ss += shx(ss, 1, lane); ss += shx(ss, 2, lane); ss += shx(ss, 4, lane);
                    const float sc = (s3 == 0 ? 0.125f : 1.f) / sqrtf(ss + EPS);
#pragma unroll
                    for (int i = 0; i < 8; ++i) y[s3][i] *= sc; }
            }
            __syncthreads();
            v4u pk[3];
#pragma unroll
            for (int s3 = 0; s3 < 3; ++s3) { pk[s3] = (v4u){pk2(y[s3][0], y[s3][1]), pk2(y[s3][2], y[s3][3]), pk2(y[s3][4], y[s3][5]), pk2(y[s3][6], y[s3][7])};
                *(GAS v4u*)(CONV + tok * CONVC + s3 * 512 + h * 64 + cb) = pk[s3]; }
            *(LAS v4u*)(Kl + h4 * 9216 + r * 144 + cb * 2) = pk[1];
        }
        __syncthreads();
        { const LAS unsigned char* Kh = Kl + hh * 9216;
#pragma unroll
          for (int mi = 0; mi < 2; ++mi) { const int mt = 2 * dirw + mi;
              const pg8::bf16x8 a0 = *(const LAS pg8::bf16x8*)(Kh + (16 * mt + l15) * 144 + (8 * q4) * 2), a1 = *(const LAS pg8::bf16x8*)(Kh + (16 * mt + l15) * 144 + (32 + 8 * q4) * 2);
#pragma unroll
              for (int nt = 0; nt < 4; ++nt) { const pg8::bf16x8 b0 = *(const LAS pg8::bf16x8*)(Kh + (16 * nt + l15) * 144 + (8 * q4) * 2), b1 = *(const LAS pg8::bf16x8*)(Kh + (16 * nt + l15) * 144 + (32 + 8 * q4) * 2);
                  f32x4 c = (f32x4){0.f, 0.f, 0.f, 0.f};
                  c = __builtin_amdgcn_mfma_f32_16x16x32_bf16(a0, b0, c, 0, 0, 0); c = __builtin_amdgcn_mfma_f32_16x16x32_bf16(a1, b1, c, 0, 0, 0);
#pragma unroll
                  for (int rg = 0; rg < 4; ++rg) KK[hh * 4352 + (16 * mt + 4 * q4 + rg) * 68 + 16 * nt + l15] = c[rg]; } } }
        __syncthreads();
        { const int h = 4 * hq + hh; const size_t ga = ((size_t)ck * 64 + (dirw ? 63 - lane : lane)) * 16 + dirw * 8 + h;
          float g = LA[ga]; const float bt = BETA[ga];
#pragma unroll
          for (int o = 1; o < 64; o <<= 1) { const float t = shl_from(g, lane - o); if (lane >= o) g += t; }
          LA[ga] = g; GB[lane] = g; GB[64 + lane] = bt;
          LAS float* Lm = KK + hh * 4352;
          for (int i = 1; i < 64; ++i) { const float bi = GB[64 + i], gi = GB[i];
              if (lane < i) { const int ad = dirw ? (63 - i) * 68 + (63 - lane) : i * 68 + lane; Lm[ad] = bi * Lm[ad] * __expf(gi - g); } }
          LAS float* Sd = (LAS float*)(Kl + F.wave * 4608);
#define LROW4(row, c4) ({ f32x4 v_; if (dirw) { const f32x4 t_ = *(const LAS f32x4*)(Lm + (63 - (row)) * 68 + (60 - (c4))); v_ = (f32x4){t_[3], t_[2], t_[1], t_[0]}; } else v_ = *(const LAS f32x4*)(Lm + (row) * 68 + (c4)); v_; })
          float x[16];
#pragma unroll
          for (int i = 0; i < 16; ++i) { float acc = (i == l15) ? 1.f : 0.f;
#pragma unroll
              for (int m4 = 0; m4 < (i + 3) / 4; ++m4) { const f32x4 v = LROW4(16 * q4 + i, 16 * q4 + 4 * m4);
#pragma unroll
                  for (int t = 0; t < 4; ++t) { if (4 * m4 + t < i) acc -= v[t] * x[4 * m4 + t]; } }
              x[i] = acc; Sd[q4 * 256 + i * 16 + l15] = acc; }
          bf16* tile = TP + (((size_t)ck * 2 + dirw) * NDH + h) * 4096;
          { bf16* dst = tile + (size_t)lane * 64 + 16 * q4;
            *(GAS v4u*)dst = (v4u){pk2(x[0] * bt, x[1] * bt), pk2(x[2] * bt, x[3] * bt), pk2(x[4] * bt, x[5] * bt), pk2(x[6] * bt, x[7] * bt)};
            *(GAS v4u*)(dst + 8) = (v4u){pk2(x[8] * bt, x[9] * bt), pk2(x[10] * bt, x[11] * bt), pk2(x[12] * bt, x[13] * bt), pk2(x[14] * bt, x[15] * bt)}; }
          f32x4 To[4][4];
#define MM_L_SCR(C, aa, cc) do { const f32x4 av_ = LROW4(16 * (aa) + l15, 16 * (cc) + 4 * q4); _Pragma("unroll") for (int r_ = 0; r_ < 4; ++r_) \
              C = __builtin_amdgcn_mfma_f32_16x16x4f32(av_[r_], Sd[(cc) * 256 + (4 * q4 + r_) * 16 + l15], C, 0, 0, 0); } while (0)
#define MM_L_REG(C, aa, cc, B) do { const f32x4 av_ = LROW4(16 * (aa) + l15, 16 * (cc) + 4 * q4); _Pragma("unroll") for (int r_ = 0; r_ < 4; ++r_) \
              C = __builtin_amdgcn_mfma_f32_16x16x4f32(av_[r_], (B)[r_], C, 0, 0, 0); } while (0)
#define MM_T_REG(C, aa, B) do { const f32x4 av_ = *(const LAS f32x4*)(Sd + (aa) * 256 + l15 * 16 + 4 * q4); _Pragma("unroll") for (int r_ = 0; r_ < 4; ++r_) \
              C = __builtin_amdgcn_mfma_f32_16x16x4f32(av_[r_], (B)[r_], C, 0, 0, 0); } while (0)
#pragma unroll
          for (int bb = 0; bb < 3; ++bb) { f32x4 Mx = (f32x4){0.f, 0.f, 0.f, 0.f}, c = Mx; MM_L_SCR(Mx, bb + 1, bb); MM_T_REG(c, bb + 1, Mx); To[bb + 1][bb] = -c; }
#pragma unroll
          for (int bb = 0; bb < 2; ++bb) { f32x4 Mx = (f32x4){0.f, 0.f, 0.f, 0.f}, c = Mx; MM_L_SCR(Mx, bb + 2, bb); MM_L_REG(Mx, bb + 2, bb + 1, To[bb + 1][bb]); MM_T_REG(c, bb + 2, Mx); To[bb + 2][bb] = -c; }
          { f32x4 Mx = (f32x4){0.f, 0.f, 0.f, 0.f}, c = Mx; MM_L_SCR(Mx, 3, 0); MM_L_REG(Mx, 3, 1, To[1][0]); MM_L_REG(Mx, 3, 2, To[2][0]); MM_T_REG(c, 3, Mx); To[3][0] = -c; }
#undef MM_L_SCR
#undef MM_L_REG
#undef MM_T_REG
#undef LROW4
#pragma unroll
          for (int bb = 0; bb < 4; ++bb) { const float bj = GB[64 + 16 * bb + l15]; bf16* rowp = tile + (size_t)(16 * bb + l15) * 64 + 4 * q4;
#pragma unroll
              for (int aa = 0; aa < 4; ++aa) { if (aa == bb) continue;
                  const f32x4 t = aa > bb ? To[aa][bb] * bj : (f32x4){0.f, 0.f, 0.f, 0.f};
                  *(GAS v2u*)(rowp + 16 * aa) = (v2u){pk2(t[0], t[1]), pk2(t[2], t[3])}; } }
        }
        __syncthreads();
    }
}
__device__ __forceinline__ v4u gld16_asm(const void* p) { v4u r; asm volatile("global_load_dwordx4 %0, %1, off" : "=v"(r) : "v"(p) : "memory"); return r; }
__device__ __forceinline__ float gld4_asm(const void* p) { float r; asm volatile("global_load_dword %0, %1, off" : "=v"(r) : "v"(p) : "memory"); return r; }
__device__ __forceinline__ void ph_delta_scan(Frame& F, int l) {
    typedef pg8::bf16x8 bx8; typedef short s16x4 __attribute__((ext_vector_type(4))); typedef short v4i16_t __attribute__((ext_vector_type(4)));
    const bf16* CONV = (const bf16*)(F.ws + WS_CONV); const float* LA = (const float*)(F.ws + WS_LA); const bf16* TPB = (const bf16*)(F.ws + WS_H);
    const bf16* GOUT = (const bf16*)(F.ws + WS_GOUT); bf16* QO = (bf16*)(F.ws + WS_QO);
    float* nst = F.out + (size_t)M * D + 2 * (size_t)NPB * DEPTH * NKVH * TP * HD;
    const int lane = F.lane, slot = F.wave >> 2, gw = F.wave & 3, tg = F.tid & 255, q4 = lane >> 4, l15 = lane & 15;
    LAS unsigned char* LB = F.lds + slot * 65536;
    LAS unsigned char* KL = LB; LAS unsigned char* QL = LB + 9216; LAS unsigned char* TL = LB + 18432; LAS unsigned char* PL = LB + 27648; LAS unsigned char* VL = LB + 36864;
    LAS float* OL = (LAS float*)(LB + 46080);
    LAS float* GL = (LAS float*)(LB + 63488);
    const int orow_i = tg >> 2, ocq = (tg & 3) * 16;
#define LBAR() do { asm volatile("s_waitcnt lgkmcnt(0)" ::: "memory"); __builtin_amdgcn_s_barrier(); asm volatile("" ::: "memory"); } while (0)
#define TRD(p) __builtin_bit_cast(s16x4, __builtin_amdgcn_ds_read_tr16_b64_v4i16((LAS v4i16_t*)(p)))
#define A_ROW(IMG, row, s) ({ const v2u lo_ = *(const LAS v2u*)((IMG) + (row) * 144 + (32 * (s) + 4 * q4) * 2), hi_ = *(const LAS v2u*)((IMG) + (row) * 144 + (32 * (s) + 16 + 4 * q4) * 2); __builtin_bit_cast(bx8, (v4u){lo_.x, lo_.y, hi_.x, hi_.y}); })
#define A_TRN(IMG, mt, s) ({ const s16x4 lo_ = TRD((IMG) + (32 * (s) + 4 * q4 + (l15 >> 2)) * 144 + (16 * (mt) + 4 * (l15 & 3)) * 2), hi_ = TRD((IMG) + (32 * (s) + 16 + 4 * q4 + (l15 >> 2)) * 144 + (16 * (mt) + 4 * (l15 & 3)) * 2); (bx8){lo_[0], lo_[1], lo_[2], lo_[3], hi_[0], hi_[1], hi_[2], hi_[3]}; })
#define PACKB(X, s) __builtin_bit_cast(bx8, pg8::pack8((X)[2 * (s)], (X)[2 * (s) + 1]))
    for (int ii = 0;; ++ii) {
        int p;
        if (F.G == 256) {
            const int jj = (F.bid >> 3) - 8;
            if (F.bid < 64) { if (ii > 1) break; p = ii == 0 ? F.bid : 64 + F.bid; }
            else if (jj >= 16) { if (ii > 2) break; p = 64 + 64 + ((F.bid & 7) * 8 + (jj - 16)) + 64 * ii; }
            else break;
        } else { if (F.bid < 64) { if (ii) break; p = F.bid; } else { p = 64 + (F.bid - 64) + ii * (F.G - 64); if (p >= 64 + NPB * NDH) break; } }
        const bool samp = p < 64; const bool active = !samp || slot == 0;
        const int pp = samp ? p : p - 64, b = samp ? pp >> 4 : pp >> 3, h = samp ? (pp >> 1) & 7 : pp & 7, dir = samp ? pp & 1 : slot, n = samp ? TS / 64 : TP / 64;
        const size_t seqbase = samp ? (size_t)MP + (size_t)b * TS : (size_t)b * TP;
        f32x4 S[4];
        if (samp && active) { const float* s0 = F.in[5] + ((((size_t)b * DEPTH + l) * 2 + dir) * NDH + h) * 4096 + 16 * gw + l15 + (4 * q4) * 64;
#pragma unroll
            for (int dt = 0; dt < 4; ++dt) {
#pragma unroll
                for (int rg = 0; rg < 4; ++rg) S[dt][rg] = *(const GAS float*)(s0 + (16 * dt + rg) * 64);
                asm volatile("" ::: "memory"); } }
        else {
#pragma unroll
            for (int dt = 0; dt < 4; ++dt) S[dt] = (f32x4){0.f, 0.f, 0.f, 0.f}; }
        v4u kr[2], qr[2], vr[2], tr_[2]; float gr = 0.f;
#define D2_LOAD(s_) do { const int cidx_ = dir ? n - 1 - (s_) : (s_); const size_t tbn_ = seqbase + (size_t)64 * cidx_; \
        _Pragma("unroll") for (int k_ = 0; k_ < 2; ++k_) { const int pc_ = tg + 256 * k_, i_ = pc_ >> 3, c8_ = pc_ & 7; const bf16* rp_ = CONV + (tbn_ + (dir ? 63 - i_ : i_)) * CONVC + h * 64 + c8_ * 8; \
            qr[k_] = gld16_asm(rp_); kr[k_] = gld16_asm(rp_ + 512); vr[k_] = gld16_asm(rp_ + 1024); \
            tr_[k_] = gld16_asm(TPB + ((((tbn_ >> 6) * 2 + dir) * NDH + h) * 4096) + (size_t)pc_ * 8); } \
        if (tg < 64) gr = gld4_asm(LA + (tbn_ + (dir ? 63 - tg : tg)) * 16 + dir * 8 + h); } while (0)
#define D2_STORE() do { asm volatile("s_waitcnt vmcnt(0)" : "+v"(kr[0]), "+v"(kr[1]), "+v"(qr[0]), "+v"(qr[1]), "+v"(vr[0]), "+v"(vr[1]), "+v"(tr_[0]), "+v"(tr_[1]), "+v"(gr) :: "memory"); \
        _Pragma("unroll") for (int k_ = 0; k_ < 2; ++k_) { const int pc_ = tg + 256 * k_, i_ = pc_ >> 3, c8_ = pc_ & 7; \
            *(LAS v4u*)(KL + i_ * 144 + c8_ * 16) = kr[k_]; *(LAS v4u*)(QL + i_ * 144 + c8_ * 16) = qr[k_]; *(LAS v4u*)(VL + i_ * 144 + c8_ * 16) = vr[k_]; *(LAS v4u*)(TL + i_ * 144 + c8_ * 16) = tr_[k_]; } \
        if (tg < 64) GL[tg] = gr; } while (0)
        if (active) { D2_LOAD(0); D2_STORE(); }
        LBAR();
        for (int s = 0; s < n; ++s) {
            const size_t tb = seqbase + (size_t)64 * (dir ? n - 1 - s : s);
            if (active && s + 1 < n) D2_LOAD(s + 1);
            if (active) {
            { f32x4 a[4];
#pragma unroll
              for (int mt = 0; mt < 4; ++mt) a[mt] = (f32x4){0.f, 0.f, 0.f, 0.f};
#pragma unroll
              for (int ks = 0; ks < 2; ++ks) { const bx8 bq = *(const LAS bx8*)(QL + (16 * gw + l15) * 144 + (32 * ks + 8 * q4) * 2);
#pragma unroll
                  for (int mt = 0; mt < 4; ++mt) { const bx8 ak = *(const LAS bx8*)(KL + (16 * mt + l15) * 144 + (32 * ks + 8 * q4) * 2); a[mt] = __builtin_amdgcn_mfma_f32_16x16x32_bf16(ak, bq, a[mt], 0, 0, 0); } }
              const int c = 16 * gw + l15; const float gc = GL[c];
#pragma unroll
              for (int mt = 0; mt < 4; ++mt) { const f32x4 gj = *(const LAS f32x4*)(GL + 16 * mt + 4 * q4); f32x4 w;
#pragma unroll
                  for (int rg = 0; rg < 4; ++rg) { const int cj = 16 * mt + 4 * q4 + rg; w[rg] = (c >= cj) ? a[mt][rg] * __expf(gc - gj[rg]) : 0.f; }
                  *(LAS v2u*)(PL + c * 144 + (16 * mt + 4 * q4) * 2) = (v2u){pg8::cvt_pk_bf16(w[0], w[1]), pg8::cvt_pk_bf16(w[2], w[3])}; } }
            }
            LBAR();
            if (active) {
            { const float glast = GL[63]; f32x4 eg4[4];
#pragma unroll
              for (int ct = 0; ct < 4; ++ct) { const f32x4 g4 = *(const LAS f32x4*)(GL + 16 * ct + 4 * q4); eg4[ct] = (f32x4){__expf(g4[0]), __expf(g4[1]), __expf(g4[2]), __expf(g4[3])}; }
              const float egl = __expf(glast);
              const LAS unsigned char* vbase = VL + (4 * q4) * 144 + (16 * gw + l15) * 2;
              bx8 fa[4][2], fb[4][2];
#pragma unroll
              for (int ct = 0; ct < 4; ++ct) { fa[ct][0] = A_ROW(KL, 16 * ct + l15, 0); fa[ct][1] = A_ROW(KL, 16 * ct + l15, 1); }
#pragma unroll
              for (int ct = 0; ct < 4; ++ct) { fb[ct][0] = A_TRN(TL, ct, 0); fb[ct][1] = A_TRN(TL, ct, 1); }
              __builtin_amdgcn_sched_barrier(0);
              const bx8 sb0 = PACKB(S, 0), sb1 = PACKB(S, 1);
              f32x4 R[4];
#pragma unroll
              for (int ct = 0; ct < 4; ++ct) { f32x4 ksv = (f32x4){0.f, 0.f, 0.f, 0.f};
                  ksv = __builtin_amdgcn_mfma_f32_16x16x32_bf16(fa[ct][0], sb0, ksv, 0, 0, 0); ksv = __builtin_amdgcn_mfma_f32_16x16x32_bf16(fa[ct][1], sb1, ksv, 0, 0, 0);
#pragma unroll
                  for (int rg = 0; rg < 4; ++rg) R[ct][rg] = bf2f(*(const LAS unsigned short*)(vbase + (16 * ct + rg) * 144)) - eg4[ct][rg] * ksv[rg]; }
#pragma unroll
              for (int ct = 0; ct < 4; ++ct) { fa[ct][0] = A_ROW(QL, 16 * ct + l15, 0); fa[ct][1] = A_ROW(QL, 16 * ct + l15, 1); }
              __builtin_amdgcn_sched_barrier(0);
              const bx8 rb0 = PACKB(R, 0), rb1 = PACKB(R, 1);
              f32x4 U[4];
#pragma unroll
              for (int ct = 0; ct < 4; ++ct) { f32x4 u = (f32x4){0.f, 0.f, 0.f, 0.f};
                  u = __builtin_amdgcn_mfma_f32_16x16x32_bf16(fb[ct][0], rb0, u, 0, 0, 0); u = __builtin_amdgcn_mfma_f32_16x16x32_bf16(fb[ct][1], rb1, u, 0, 0, 0); U[ct] = u; }
#pragma unroll
              for (int ct = 0; ct < 4; ++ct) { fb[ct][0] = A_ROW(PL, 16 * ct + l15, 0); fb[ct][1] = A_ROW(PL, 16 * ct + l15, 1); }
              __builtin_amdgcn_sched_barrier(0);
              f32x4 O[4];
#pragma unroll
              for (int ct = 0; ct < 4; ++ct) { f32x4 o = (f32x4){0.f, 0.f, 0.f, 0.f};
                  o = __builtin_amdgcn_mfma_f32_16x16x32_bf16(fa[ct][0], sb0, o, 0, 0, 0); o = __builtin_amdgcn_mfma_f32_16x16x32_bf16(fa[ct][1], sb1, o, 0, 0, 0); O[ct] = o * eg4[ct]; }
#pragma unroll
              for (int dt = 0; dt < 4; ++dt) { fa[dt][0] = A_TRN(KL, dt, 0); fa[dt][1] = A_TRN(KL, dt, 1); }
              __builtin_amdgcn_sched_barrier(0);
              const bx8 ub0 = PACKB(U, 0), ub1 = PACKB(U, 1);
#pragma unroll
              for (int ct = 0; ct < 4; ++ct) { f32x4 o = O[ct];
                  o = __builtin_amdgcn_mfma_f32_16x16x32_bf16(fb[ct][0], ub0, o, 0, 0, 0); o = __builtin_amdgcn_mfma_f32_16x16x32_bf16(fb[ct][1], ub1, o, 0, 0, 0);
#pragma unroll
                  for (int rg = 0; rg < 4; ++rg) OL[(16 * ct + 4 * q4 + rg) * 68 + 16 * gw + l15] = o[rg]; }
#pragma unroll
              for (int ct = 0; ct < 4; ++ct) { const f32x4 g4 = *(const LAS f32x4*)(GL + 16 * ct + 4 * q4); U[ct] = U[ct] * (f32x4){__expf(glast - g4[0]), __expf(glast - g4[1]), __expf(glast - g4[2]), __expf(glast - g4[3])}; }
              const bx8 vb0 = PACKB(U, 0), vb1 = PACKB(U, 1);
#pragma unroll
              for (int dt = 0; dt < 4; ++dt) { f32x4 sn = S[dt] * egl;
                  sn = __builtin_amdgcn_mfma_f32_16x16x32_bf16(fa[dt][0], vb0, sn, 0, 0, 0); sn = __builtin_amdgcn_mfma_f32_16x16x32_bf16(fa[dt][1], vb1, sn, 0, 0, 0); S[dt] = sn; } }
            }
            LBAR();
            if (active) {
                if (s + 1 < n) D2_STORE();
                f32x4 o4[4];
#pragma unroll
                for (int k = 0; k < 4; ++k) o4[k] = *(const LAS f32x4*)(OL + orow_i * 68 + ocq + 4 * k);
                bf16* dst = (bf16*)TPB + ((((tb >> 6) * 2 + dir) * NDH + h) * 4096) + (size_t)(dir ? 63 - orow_i : orow_i) * 64 + ocq;
                *(GAS pg8::u32x4*)dst = pg8::pack8(o4[0], o4[1]); *(GAS pg8::u32x4*)(dst + 8) = pg8::pack8(o4[2], o4[3]);
            }
            LBAR();
        }
        if (!samp) { int q4b = q4, l15b = l15; asm volatile("" : "+v"(q4b), "+v"(l15b));
            float* dst = nst + ((((size_t)b * DEPTH + l) * 2 + dir) * NDH + h) * 4096 + 16 * gw + l15b + (4 * q4b) * 64;
#pragma unroll
            for (int dt = 0; dt < 4; ++dt)
#pragma unroll
                for (int rg = 0; rg < 4; ++rg) *(GAS float*)(dst + (16 * dt + rg) * 64) = S[dt][rg]; }
    }
#undef TRD
#undef A_ROW
#undef A_TRN
#undef PACKB
#undef D2_LOAD
#undef D2_STORE
#undef LBAR
}


__device__ __forceinline__ void ph_delta_combine(Frame& F, int l) {
    const bf16* TPB = (const bf16*)(F.ws + WS_H); const bf16* GOUT = (const bf16*)(F.ws + WS_GOUT); bf16* QO = (bf16*)(F.ws + WS_QO);
    const int c8 = F.tid & 7; const f32x4 g0 = *(const GAS f32x4*)(F.in[17] + l * 64 + c8 * 8), g1 = *(const GAS f32x4*)(F.in[17] + l * 64 + c8 * 8 + 4);
    for (int u = F.bid * (NTHREADS / 8) + (F.tid >> 3); u < M * NDH; u += F.G * (NTHREADS / 8)) {
        const int row = u >> 3, h = u & 7, ck = row >> 6, t = row & 63;
        const bf16* pf = TPB + ((((size_t)ck * 2 + 0) * NDH + h) * 64 + t) * 64 + c8 * 8; const bf16* pb = pf + (size_t)NDH * 4096;
        f32x4 a0, a1, b0, b1, s0, s1; pg8::unpack8(*(const GAS pg8::u32x4*)pf, a0, a1); pg8::unpack8(*(const GAS pg8::u32x4*)pb, b0, b1);
        pg8::unpack8(*(const GAS pg8::u32x4*)(GOUT + (size_t)row * 512 + h * 64 + c8 * 8), s0, s1);
        a0 = a0 + b0; a1 = a1 + b1;
        float ss = (a0[0] * a0[0] + a0[1] * a0[1]) + (a0[2] * a0[2] + a0[3] * a0[3]) + (a1[0] * a1[0] + a1[1] * a1[1]) + (a1[2] * a1[2] + a1[3] * a1[3]);
        ss += shx(ss, 1, F.lane); ss += shx(ss, 2, F.lane); ss += shx(ss, 4, F.lane);
        const float rstd = __builtin_amdgcn_rsqf(ss * (1.f / 64.f) + EPS);
        *(GAS pg8::u32x4*)(QO + (size_t)row * D + 512 + h * 64 + c8 * 8) = pg8::pack8(a0 * rstd * g0 * s0, a1 * rstd * g1 * s1);
    }
}
__global__ void __launch_bounds__(NTHREADS, 2) mk_fwd(Args args) {
    extern __shared__ __attribute__((aligned(16))) unsigned char lds[];
    Frame F;
    F.lds = (LAS unsigned char*)lds; F.tid = threadIdx.x; F.lane = F.tid & 63; F.wave = __builtin_amdgcn_readfirstlane(F.tid >> 6); F.G = gridDim.x; F.bid = blockIdx.x;
    const int wave0 = F.wave;
    F.in = args.in; F.out = args.out; F.ws = args.ws;
    volatile LAS unsigned* MISC = (volatile LAS unsigned*)(F.lds + MISC_OFF);
    if (F.tid < 32) MISC[F.tid] = 0u;
    __syncthreads();
    XcdBarrier bar; bar.bar = (unsigned*)(F.ws + WS_CTL) + CW_BAR; bar.x = 0; bar.st = nullptr;
#if MK_ONE_LAUNCH
    bar = xcd_barrier_post((unsigned*)(F.ws + WS_CTL) + CW_BAR, MISC + 8);
#endif
    const int lo = args.ph_lo, hi = args.ph_hi; int ph = 0;
#define REFRESH() do { int t_; asm volatile("v_mbcnt_lo_u32_b32 %0, -1, 0\n\tv_mbcnt_hi_u32_b32 %0, -1, %0" : "=v"(t_)); t_ += wave0 * 64; F.tid = t_; F.lane = t_ & 63; F.wave = __builtin_amdgcn_readfirstlane(t_ >> 6); \
        unsigned char* w_ = args.ws; asm volatile("" : "+s"(w_)); F.ws = w_; float* o_ = args.out; asm volatile("" : "+s"(o_)); F.out = o_; } while (0)
#if MK_ONE_LAUNCH
#define PHASE(...) do { REFRESH(); __VA_ARGS__; bar.bar = (unsigned*)(F.ws + WS_CTL) + CW_BAR; xcd_barrier(bar, F.tid); ++ph; } while (0)
#else
#define PHASE(...) do { if (ph >= lo && ph < hi) { REFRESH(); __VA_ARGS__; } ++ph; } while (0)
#endif
    PHASE(ph_prologue(F); ph_convert_weights(F, 0, 0, F.G, F.bid));
    for (int l = 0; l < DEPTH; ++l) {
        if (l == 0) PHASE(ph_modnorm(F, l, 0, true); ph_sb1(F));
        else PHASE(ph_convert_weights(F, l, F.G == 256 ? 2 : 0, F.G, F.bid); ph_modnorm(F, l, 0, false));
        PHASE(ph_projA(F, l));
        PHASE(ph_delta_pre(F, l));
        PHASE(ph_delta_scan(F, l); attn_units(F, (char*)lds));
        PHASE(ph_delta_combine(F, l));
        PHASE(ph_modnorm(F, l, 0, l == 0));
        PHASE(ph_gates(F));
        PHASE(ph_merge(F));
        PHASE(ph_outproj(F, l, l == 0));
#pragma clang loop unroll(disable)
        for (int fp = 0; fp < 4; ++fp) {
            const bool bal = F.G == 256;
            PHASE(
                if (fp == 1 || fp == 3) ph_ffn2(F, l, fp == 1 ? 0 : M / 2, (fp == 3 && bal) ? 16 : 0);
                int r0 = 0, nrt = 0, nw = F.G, c = F.bid; bf16* out = (bf16*)(F.ws + WS_FF);
                if (fp == 0) { r0 = 0; nrt = 48; }
                else if (fp == 1) { if (bal && F.bid >= 192) { r0 = M / 2; nrt = 16; nw = 64; c = F.bid - 192; out = (bf16*)(F.ws + WS_H); } }
                else if (fp == 2) { if (bal) { r0 = M / 2 + 16 * 256; nrt = 32; out += (size_t)16 * 256 * FF; } else { r0 = M / 2; nrt = 48; } }
                if (nrt) ffn1_units(F, l, r0, nrt, out, nw, c);
                if (fp == 3 && bal && l + 1 < DEPTH && F.bid >= 192) ph_convert_weights(F, l + 1, 1, 64, F.bid - 192);
            );
        }
    }
    PHASE(ph_final_norm(F));
}
constexpr int N_PHASES = 1 + DEPTH * 13 + 1;

extern "C" void kernel_launch(void* const* d_in, const int* in_sizes, int n_in, void* d_out, int out_size, void* d_ws, size_t ws_size, hipStream_t stream) {
    static int grid = 0;
    if (grid == 0) {
        if (n_in != 26 || ws_size < WS_END) { fprintf(stderr, "kernel_launch: unexpected n_in %d / ws %zu\n", n_in, ws_size); grid = -1; return; }
        int dev = 0, cus = 0;
        if (hipGetDevice(&dev) != hipSuccess || hipDeviceGetAttribute(&cus, hipDeviceAttributeMultiprocessorCount, dev) != hipSuccess) { grid = -1; return; }
        if (hipFuncSetAttribute((const void*)mk_fwd, hipFuncAttributeMaxDynamicSharedMemorySize, LDS_BYTES) != hipSuccess) { grid = -1; return; }
        int per_cu = 0;
        if (hipOccupancyMaxActiveBlocksPerMultiprocessor(&per_cu, (const void*)mk_fwd, NTHREADS, LDS_BYTES) != hipSuccess || per_cu < 1) { fprintf(stderr, "kernel_launch: occupancy query says %d blocks per CU\n", per_cu); grid = -1; return; }
        (void)hipGetLastError();
        grid = cus;
    }
    if (grid < 0) return;
    (void)hipMemsetAsync((char*)d_ws + WS_CTL, 0, CTL_ZERO_BYTES, stream);
    Args a{};
    for (int i = 0; i < 26; ++i) a.in[i] = (const float*)d_in[i];
    a.out = (float*)d_out; a.ws = (unsigned char*)d_ws;
#if MK_ONE_LAUNCH
    a.ph_lo = 0; a.ph_hi = N_PHASES;
    void* kargs[] = {&a};
    hipError_t e = hipLaunchCooperativeKernel((const void*)mk_fwd, dim3(grid), dim3(NTHREADS), kargs, LDS_BYTES, stream);
    if (e != hipSuccess) fprintf(stderr, "kernel_launch: cooperative launch failed: %s (grid %d)\n", hipGetErrorString(e), grid);
#else
    for (int p = 0; p < N_PHASES; ++p) { a.ph_lo = p; a.ph_hi = p + 1; hipLaunchKernelGGL(mk_fwd, dim3(grid), dim3(NTHREADS), LDS_BYTES, stream, a); }
#endif
}
```
